# Optimizing an MI355X kernel written in HIP

```python
import jax, jax.numpy as jnp
from jax import lax
import numpy as np

D_MODEL = 1024
BATCH = 8
SEQ = 2048
DEPTH = 1
DEC_BATCH = 128
DEC_SEQ = 4
PAST_LEN = 8192
PAGE_SIZE = 128

HEAD_DIM = 64
N_HEADS_A = 8
N_HEADS_B = 8
WIDTH_A = N_HEADS_A * HEAD_DIM
WIDTH_B = N_HEADS_B * HEAD_DIM
MIX_WIDTH = WIDTH_A + WIDTH_B
IN_WIDTH = 2 * WIDTH_A + 3 * WIDTH_B
CHUNK = 128
DILATED_PATTERNS = ((128, 1), (512, 4), (2048, 16))
MAX_WINDOW = max(w for w, _ in DILATED_PATTERNS)
ATTN_BLOCK = 128
D_FF = ((8 * D_MODEL + 3 * 256 - 1) // (3 * 256)) * 256
EPS = 1e-6

kernel_name = "hymba_gmlp_dilated_swa_decode"

F32 = jnp.float32


def rms_norm(x, g):
    xf = x.astype(F32)
    y = xf * lax.rsqrt(jnp.mean(xf * xf, axis=-1, keepdims=True) + EPS)
    return (y * g.astype(F32)).astype(x.dtype)


def layer_norm(x, g, b):
    xf = x.astype(F32)
    mu = jnp.mean(xf, axis=-1, keepdims=True)
    xc = xf - mu
    y = xc * lax.rsqrt(jnp.mean(xc * xc, axis=-1, keepdims=True) + EPS)
    return y * g.astype(F32) + b.astype(F32)


def _in_proj(x, g_attn, w_in):
    z = rms_norm(x, g_attn) @ w_in
    o1 = WIDTH_A
    o2 = o1 + WIDTH_A
    o3 = o2 + WIDTH_B
    o4 = o3 + WIDTH_B
    return z[..., :o1], z[..., o1:o2], z[..., o2:o3], z[..., o3:o4], z[..., o4:]


def _gmlp_features(zu, zv, ln_g, ln_b):
    u = jax.nn.gelu(zu.astype(F32))
    vn = layer_norm(jax.nn.gelu(zv.astype(F32)), ln_g, ln_b)
    return u, vn


def _spatial_gate(u, vn, w_s, b_s):
    N, L, _ = vn.shape
    c = min(CHUNK, L)
    nc = L // c
    tri = jnp.tril(jnp.ones((c, c), dtype=bool))
    ws = jnp.where(tri, w_s[:, :c, :c].astype(F32), 0.0)
    vr = vn.reshape(N, nc, c, N_HEADS_A, HEAD_DIM)
    s = jnp.einsum('hij,bnjhd->bnihd', ws, vr)
    s = s + b_s[:, :c].astype(F32).T[None, None, :, :, None]
    return u * s.reshape(N, L, WIDTH_A)


def _qkv(zq, zk, zv, g_q, g_k):
    shp = zq.shape[:-1] + (N_HEADS_B, HEAD_DIM)
    q = rms_norm(zq.reshape(shp), g_q).astype(F32) * (HEAD_DIM ** -0.5)
    k = rms_norm(zk.reshape(shp), g_k).astype(F32)
    v = zv.reshape(shp).astype(F32)
    return q, k, v


def _band_stats(q, k, v, n_back):
    N, L, H, Dh = q.shape
    blk = min(ATTN_BLOCK, L)
    nb = -(-L // blk)
    Lp = nb * blk
    pad = ((0, 0), (0, Lp - L), (0, 0), (0, 0))
    q, k, v = jnp.pad(q, pad), jnp.pad(k, pad), jnp.pad(v, pad)
    qb = q.reshape(N, nb, blk, H, Dh)

    def with_prev(a):
        ab = a.reshape(N, nb, blk, H, Dh)
        prev = jnp.pad(ab, ((0, 0), (1, 0), (0, 0), (0, 0), (0, 0)))[:, :-1]
        return jnp.concatenate([prev, ab], axis=2)

    kk, vv = with_prev(k), with_prev(v)
    s = jnp.einsum('nbihd,nbjhd->nbhij', qb, kk)
    qpos = jnp.arange(nb)[:, None] * blk + jnp.arange(blk)[None, :]
    kpos = jnp.arange(nb)[:, None] * blk - blk + jnp.arange(2 * blk)[None, :]
    dist = qpos[:, :, None] - kpos[:, None, :]
    valid = (dist >= 0) & (dist <= n_back) & (kpos[:, None, :] >= 0)
    s = jnp.where(valid[None, :, None], s, -jnp.inf)
    m = jnp.max(s, axis=-1)
    p = jnp.exp(s - m[..., None])
    l = jnp.sum(p, axis=-1)
    acc = jnp.einsum('nbhij,nbjhd->nbihd', p, vv).reshape(N, Lp, H, Dh)[:, :L]
    m = jnp.swapaxes(m, 2, 3).reshape(N, Lp, H)[:, :L]
    l = jnp.swapaxes(l, 2, 3).reshape(N, Lp, H)[:, :L]
    return m, l, acc


def _dilated_branch_prompt(q, k, v, window, dil):
    B, S, H, Dh = q.shape
    L = S // dil

    def to_res(a):
        return jnp.swapaxes(a.reshape(B, L, dil, H, Dh), 1, 2).reshape(B * dil, L, H, Dh)

    def from_res(a):
        a = a.reshape((B, dil) + a.shape[1:])
        return jnp.swapaxes(a, 1, 2).reshape((B, S) + a.shape[3:])

    m, l, acc = _band_stats(to_res(q), to_res(k), to_res(v), window // dil)
    return from_res(m), from_res(l), from_res(acc)


def _dilated_branch_sample(q, k_all, v_all, window, dil):
    T = q.shape[1]
    Lb = k_all.shape[1] - T
    n_keys = window // dil + 1
    idx = Lb + jnp.arange(T)[:, None] - dil * jnp.arange(n_keys)[None, :]
    valid = (idx >= 0) & (idx + (PAST_LEN - Lb) >= 0)
    idx_c = jnp.clip(idx, 0)
    kg = k_all[:, idx_c]
    vg = v_all[:, idx_c]
    s = jnp.einsum('nthd,ntjhd->nthj', q, kg)
    s = jnp.where(valid[None, :, None, :], s, -jnp.inf)
    m = jnp.max(s, axis=-1)
    p = jnp.exp(s - m[..., None])
    l = jnp.sum(p, axis=-1)
    acc = jnp.einsum('nthj,ntjhd->nthd', p, vg)
    return m, l, acc


def _combine(stats):
    m_all = jnp.stack([st[0] for st in stats])
    l_all = jnp.stack([st[1] for st in stats])
    acc_all = jnp.stack([st[2] for st in stats])
    w = jnp.exp(m_all - jnp.max(m_all, axis=0, keepdims=True))
    num = jnp.sum(w[..., None] * acc_all, axis=0)
    den = jnp.sum(w * l_all, axis=0)
    return num / den[..., None]


def _finish(x, a_out, b_out, g_out_a, g_out_b, w_o, g_ffn, w_gate, w_up, w_down):
    lead = b_out.shape[:2]
    mix = jnp.concatenate([rms_norm(a_out, g_out_a), rms_norm(b_out.reshape(lead + (WIDTH_B,)), g_out_b)], axis=-1)
    x = x + mix.astype(x.dtype) @ w_o
    h = rms_norm(x, g_ffn)
    return x + (jax.nn.silu(h @ w_gate) * (h @ w_up)) @ w_down


def setup_inputs(seed: int = 0) -> dict:
    key = jax.random.key(seed)
    ks = jax.random.split(key, 24)
    win_buf = min(MAX_WINDOW, PAST_LEN)
    nrm = lambda k, shp, s: jax.random.normal(k, shp, F32) * s
    gain = lambda k, shp: 1.0 + 0.05 * jax.random.normal(k, shp, F32)
    return {
        "x_prompt": nrm(ks[0], (BATCH, SEQ, D_MODEL), 1.0),
        "x_sample": nrm(ks[1], (DEC_BATCH, DEC_SEQ, D_MODEL), 1.0),
        "cache_k": nrm(ks[2], (DEPTH, DEC_BATCH, win_buf, N_HEADS_B, HEAD_DIM), 1.0),
        "cache_v": nrm(ks[3], (DEPTH, DEC_BATCH, win_buf, N_HEADS_B, HEAD_DIM), 1.0),
        "g_attn": gain(ks[4], (DEPTH, D_MODEL)),
        "w_in": nrm(ks[5], (DEPTH, D_MODEL, IN_WIDTH), D_MODEL ** -0.5),
        "ln_v_g": gain(ks[6], (DEPTH, WIDTH_A)),
        "ln_v_b": nrm(ks[7], (DEPTH, WIDTH_A), 0.02),
        "w_s": nrm(ks[8], (DEPTH, N_HEADS_A, CHUNK, CHUNK), CHUNK ** -0.5),
        "b_s": 1.0 + nrm(ks[9], (DEPTH, N_HEADS_A, CHUNK), 0.02),
        "g_q": gain(ks[10], (DEPTH, HEAD_DIM)),
        "g_k": gain(ks[11], (DEPTH, HEAD_DIM)),
        "g_out_a": gain(ks[12], (DEPTH, WIDTH_A)),
        "g_out_b": gain(ks[13], (DEPTH, WIDTH_B)),
        "w_o": nrm(ks[14], (DEPTH, MIX_WIDTH, D_MODEL), MIX_WIDTH ** -0.5),
        "g_ffn": gain(ks[15], (DEPTH, D_MODEL)),
        "w_gate": nrm(ks[16], (DEPTH, D_MODEL, D_FF), D_MODEL ** -0.5),
        "w_up": nrm(ks[17], (DEPTH, D_MODEL, D_FF), D_MODEL ** -0.5),
        "w_down": nrm(ks[18], (DEPTH, D_FF, D_MODEL), D_FF ** -0.5),
    }


def reference(x_prompt, x_sample, cache_k, cache_v, g_attn, w_in, ln_v_g, ln_v_b, w_s, b_s,
              g_q, g_k, g_out_a, g_out_b, w_o, g_ffn, w_gate, w_up, w_down):
    xp, xs = x_prompt, x_sample
    win_p = min(MAX_WINDOW, xp.shape[1])
    kp_l, vp_l, ksm_l, vsm_l, cs_l = [], [], [], [], []
    for l in range(DEPTH):
        zu, zv, zq, zk, zvb = _in_proj(xp, g_attn[l], w_in[l])
        u, vn = _gmlp_features(zu, zv, ln_v_g[l], ln_v_b[l])
        a_out = _spatial_gate(u, vn, w_s[l], b_s[l])
        q, k, v = _qkv(zq, zk, zvb, g_q[l], g_k[l])
        b_out = _combine([_dilated_branch_prompt(q, k, v, wd, dl) for wd, dl in DILATED_PATTERNS])
        new_xp = _finish(xp, a_out, b_out, g_out_a[l], g_out_b[l], w_o[l], g_ffn[l], w_gate[l], w_up[l], w_down[l])
        kp_l.append(k[:, -win_p:].astype(xp.dtype))
        vp_l.append(v[:, -win_p:].astype(xp.dtype))

        zu, zv, zq, zk, zvb = _in_proj(xs, g_attn[l], w_in[l])
        u, vn = _gmlp_features(zu, zv, ln_v_g[l], ln_v_b[l])
        a_out = _spatial_gate(u, vn, w_s[l], b_s[l])
        q, k, v = _qkv(zq, zk, zvb, g_q[l], g_k[l])
        k_all = jnp.concatenate([cache_k[l].astype(F32), k], axis=1)
        v_all = jnp.concatenate([cache_v[l].astype(F32), v], axis=1)
        b_out = _combine([_dilated_branch_sample(q, k_all, v_all, wd, dl) for wd, dl in DILATED_PATTERNS])
        new_xs = _finish(xs, a_out, b_out, g_out_a[l], g_out_b[l], w_o[l], g_ffn[l], w_gate[l], w_up[l], w_down[l])
        ksm_l.append(k.astype(xs.dtype))
        vsm_l.append(v.astype(xs.dtype))
        cs_l.append(vn.astype(xs.dtype))
        xp, xs = new_xp, new_xs
    return (xp, xs, jnp.stack(kp_l), jnp.stack(vp_l), jnp.stack(ksm_l), jnp.stack(vsm_l), jnp.stack(cs_l))
```

```cpp
#include <hip/hip_runtime.h>
#include <cstdio>
#include <cstdint>
namespace pg8 {
#define PG8_LAS __attribute__((address_space(3)))
typedef unsigned short bf16_t;
typedef short bf16x8 __attribute__((ext_vector_type(8)));
typedef float f32x4 __attribute__((ext_vector_type(4)));
typedef unsigned u32x4 __attribute__((ext_vector_type(4)));
constexpr int BM = 256, BK = 64, HALF = 128, HTB = HALF * BK * 2  , STAGE_BYTES = 8 * HTB, NXCD = 8, WGM = 8;

__host__ __device__ __forceinline__ int lds_byte(int r, int c) { const int st = (r >> 4) * 2 + (c >> 5), rr = r & 15, cc = c & 31, ob = rr * 64 + cc * 2; return st * 1024 + (ob ^ (((ob >> 9) & 1) << 5)); }
__host__ __device__ __forceinline__ void stage_rc(int b, int& R, int& C) { const int st = b / 1024, sb = b % 1024, swz = sb ^ (((sb >> 9) & 1) << 5); R = (st >> 1) * 16 + swz / 64; C = (st & 1) * 32 + (swz % 64) / 2; }
__host__ __device__ __forceinline__ int perm32(int rho) { const int n = rho >> 4, i = rho & 15; return 8 * (i >> 2) + 4 * n + (i & 3); }

__host__ __device__ __forceinline__ int invperm32(int x) { return 16 * ((x >> 2) & 1) + 4 * (x >> 3) + (x & 3); }
__host__ __device__ __forceinline__ size_t img_off(int row, int col, int nkt) { return ((size_t)((row >> 7) * nkt + (col >> 6)) << 14) + (size_t)lds_byte(row & 127, col & 63); }
__host__ __device__ __forceinline__ size_t img_off_b(int row, int col, int nkt) { return img_off((row & ~31) | invperm32(row & 31), col, nkt); }
struct Unit { int pm, pn; };
struct Gemm { const bf16_t* A; const bf16_t* Bt; int M, N, K; };

struct StaticOrder {
    int nM, nN, nwg, G, c;
    __host__ __device__ void init(int M, int N, int G_, int c_) { nM = M / BM; nN = N / BM; nwg = nM * nN; G = G_; c = c_; }
    __host__ __device__ bool next(int i, Unit& u) const {
        const long L = (long)i * G + c; if (L >= nwg) return false;
        int wgid = (int)L; { const int q = nwg / NXCD, r = nwg % NXCD, xcd = wgid % NXCD, off = wgid / NXCD; wgid = (xcd < r ? xcd * (q + 1) : r * (q + 1) + (xcd - r) * q) + off; }
        const int nig = WGM * nN, gid = wgid / nig, fm = gid * WGM, gsz = (nM - fm) < WGM ? (nM - fm) : WGM;
        u.pm = fm + ((wgid % nig) % gsz); u.pn = (wgid % nig) / gsz; return true;
    }
    __device__ __forceinline__ void a_ready(const Unit&) const {}
    __device__ __forceinline__ void done(const Unit&) const {}
};

__device__ __forceinline__ unsigned cvt_pk_bf16(float lo, float hi) { unsigned r; asm volatile("v_cvt_pk_bf16_f32 %0, %1, %2" : "=v"(r) : "v"(lo), "v"(hi)); return r; }
typedef float f32x2 __attribute__((ext_vector_type(2)));
__device__ __forceinline__ float fast_exp2(float x) { return __builtin_amdgcn_exp2f(x); }
__device__ __forceinline__ float fast_rcp(float x) { return __builtin_amdgcn_rcpf(x); }
__device__ __forceinline__ float gelu_t(float x) { const float u = 0.7978845608028654f * (x + 0.044715f * x * x * x); return x * fast_rcp(1.0f + fast_exp2(-2.8853900817779268f * u)); }
__device__ __forceinline__ float silu_f(float x) { return x * fast_rcp(1.0f + fast_exp2(-1.4426950408889634f * x)); }
__device__ __forceinline__ float quad_sum(float s) { s += __shfl_xor(s, 16); s += __shfl_xor(s, 32); return s; }

constexpr size_t EW_U = 66u << 20, EW_GV = 83u << 20, EW_Q = 100u << 20, EW_K = 117u << 20, EW_V = 134u << 20, EW_X1B = 186u << 20, EW_H = 220u << 20;
constexpr int EC_ST1 = 16384, EC_ST2 = EC_ST1 + 16896, EC_SS = EC_ST2 + 16896;
constexpr size_t EO_KP = (size_t)16896 * 1024, EO_VP = EO_KP + (size_t)16384 * 512, EO_KS = EO_VP + (size_t)16384 * 512, EO_VS = EO_KS + (size_t)512 * 512;
constexpr int XM_PROMPT = 16384;
constexpr float QSCALE = 0.125f * 1.4426950408889634f;

struct EpiIn {
    static constexpr bool PERM = true, AFTER_DRAIN = false;
    unsigned char* ws; float* out; const float *gq, *gk;
    __device__ __forceinline__ void operator()(const f32x4 (&acc)[2][2][4][2], const Unit& u, int wr, int wc, int fr, int fq) const {
        const int row0 = u.pm * BM + wr * 64 + fr; const int pn = u.pn;
        if (pn < 4) {
            bf16_t* dst = (bf16_t*)(ws + ((pn < 2) ? EW_U : EW_GV)); float* st1 = (float*)ws + EC_ST1; float* st2 = (float*)ws + EC_ST2; const int col0 = (pn & 1) * 256 + wc * 32 + 8 * fq; const bool stats = pn >= 2;
#pragma unroll
            for (int ai = 0; ai < 2; ++ai)
#pragma unroll
                for (int m = 0; m < 4; ++m) { const int row = row0 + ai * HALF + m * 16; bf16_t* rowp = dst + (size_t)row * 512 + col0; float s1 = 0.f, s2 = 0.f;
#pragma unroll
                    for (int bj = 0; bj < 2; ++bj) { f32x4 v0 = acc[ai][bj][m][0], v1 = acc[ai][bj][m][1];
#pragma unroll
                        for (int j = 0; j < 4; ++j) { v0[j] = gelu_t(v0[j]); v1[j] = gelu_t(v1[j]); }
                        s1 += (v0[0] + v0[1]) + (v0[2] + v0[3]) + (v1[0] + v1[1]) + (v1[2] + v1[3]);
                        s2 += (v0[0] * v0[0] + v0[1] * v0[1]) + (v0[2] * v0[2] + v0[3] * v0[3]) + (v1[0] * v1[0] + v1[1] * v1[1]) + (v1[2] * v1[2] + v1[3] * v1[3]);
                        u32x4 w; w.x = cvt_pk_bf16(v0[0], v0[1]); w.y = cvt_pk_bf16(v0[2], v0[3]); w.z = cvt_pk_bf16(v1[0], v1[1]); w.w = cvt_pk_bf16(v1[2], v1[3]);
                        *(u32x4*)(rowp + bj * HALF) = w; }
                    if (stats) { s1 = quad_sum(s1); s2 = quad_sum(s2); if (fq == 0) { atomicAdd(st1 + row, s1); atomicAdd(st2 + row, s2); } } }
        } else {
            const int sec = pn >> 1, head = 4 * (pn & 1) + wc; const bool prompt = u.pm < (XM_PROMPT / BM);
            bf16_t* dst = (bf16_t*)(ws + ((sec == 2) ? EW_Q : (sec == 3) ? EW_K : EW_V)); const float* gp = (sec == 2) ? gq : gk;
            float* fo = (sec == 2) ? nullptr : out + ((sec == 3) ? (prompt ? EO_KP : EO_KS) : (prompt ? EO_VP : EO_VS));
            f32x4 gv[2][2];
#pragma unroll
            for (int bj = 0; bj < 2; ++bj)
#pragma unroll
                for (int n = 0; n < 2; ++n) gv[bj][n] = (sec < 4) ? *(const f32x4*)(gp + 32 * bj + 8 * fq + 4 * n) : (f32x4){1.f, 1.f, 1.f, 1.f};
            const float post = (sec == 2) ? QSCALE : 1.0f;
#pragma unroll
            for (int ai = 0; ai < 2; ++ai)
#pragma unroll
                for (int m = 0; m < 4; ++m) { const int row = row0 + ai * HALF + m * 16; const int orow = prompt ? row : row - XM_PROMPT;
                    float ss = 0.f;
#pragma unroll
                    for (int bj = 0; bj < 2; ++bj)
#pragma unroll
                        for (int n = 0; n < 2; ++n) { const f32x4 x = acc[ai][bj][m][n]; ss += (x[0] * x[0] + x[1] * x[1]) + (x[2] * x[2] + x[3] * x[3]); }
                    ss = quad_sum(ss);
                    const float rr = (sec < 4) ? post * (1.0f / sqrtf(ss * (1.0f / 64.0f) + 1e-6f)) : 1.0f;
#pragma unroll
                    for (int bj = 0; bj < 2; ++bj) { const f32x4 v0 = acc[ai][bj][m][0] * rr * gv[bj][0], v1 = acc[ai][bj][m][1] * rr * gv[bj][1];
                        const int dcol = 64 * head + 32 * bj + 8 * fq;
                        u32x4 w; w.x = cvt_pk_bf16(v0[0], v0[1]); w.y = cvt_pk_bf16(v0[2], v0[3]); w.z = cvt_pk_bf16(v1[0], v1[1]); w.w = cvt_pk_bf16(v1[2], v1[3]);
                        *(u32x4*)(dst + (size_t)row * 512 + dcol) = w;
                        if (fo) { float* op = fo + (size_t)orow * 512 + dcol; if (prompt) { __builtin_nontemporal_store(v0, (f32x4*)op); __builtin_nontemporal_store(v1, (f32x4*)(op + 4)); } else { *(f32x4*)op = v0; *(f32x4*)(op + 4) = v1; } } } }
        }
    }
};
struct EpiWo {
    static constexpr bool PERM = true, AFTER_DRAIN = false;
    const float *xp, *xs; float* y; unsigned char* ws;
    __device__ __forceinline__ void operator()(const f32x4 (&acc)[2][2][4][2], const Unit& u, int wr, int wc, int fr, int fq) const {
        const int row0 = u.pm * BM + wr * 64 + fr; const int col0 = u.pn * BM + wc * 32 + 8 * fq;
        const float* xb = (u.pm < XM_PROMPT / BM) ? xp : (xs - (size_t)XM_PROMPT * 1024); bf16_t* x1b = (bf16_t*)(ws + EW_X1B); float* ss = (float*)ws + EC_SS;
#pragma unroll
        for (int ai = 0; ai < 2; ++ai)
#pragma unroll
            for (int m = 0; m < 4; ++m) { const int row = row0 + ai * HALF + m * 16; const size_t off = (size_t)row * 1024 + col0; float s = 0.f;
#pragma unroll
                for (int bj = 0; bj < 2; ++bj) { const f32x4 x0 = *(const f32x4*)(xb + off + bj * HALF), x1 = *(const f32x4*)(xb + off + bj * HALF + 4);
                    const f32x4 v0 = acc[ai][bj][m][0] + x0, v1 = acc[ai][bj][m][1] + x1;
                    s += (v0[0] * v0[0] + v0[1] * v0[1]) + (v0[2] * v0[2] + v0[3] * v0[3]) + (v1[0] * v1[0] + v1[1] * v1[1]) + (v1[2] * v1[2] + v1[3] * v1[3]);
                    u32x4 w; w.x = cvt_pk_bf16(v0[0], v0[1]); w.y = cvt_pk_bf16(v0[2], v0[3]); w.z = cvt_pk_bf16(v1[0], v1[1]); w.w = cvt_pk_bf16(v1[2], v1[3]);
                    *(u32x4*)((char*)x1b + img_off(row, col0 + bj * HALF, 16)) = w; }
                s = quad_sum(s); if (fq == 0) atomicAdd(ss + row, s); }
    }
};
struct EpiGU {
    static constexpr bool PERM = true, AFTER_DRAIN = false;
    unsigned char* ws;
    __device__ __forceinline__ void operator()(const f32x4 (&acc)[2][2][4][2], const Unit& u, int wr, int wc, int fr, int fq) const {
        const int row0 = u.pm * BM + wr * 64 + fr; const int col0 = u.pn * HALF + wc * 32 + 8 * fq; const float* ss = (const float*)ws + EC_SS; bf16_t* H = (bf16_t*)(ws + EW_H);
#pragma unroll
        for (int ai = 0; ai < 2; ++ai)
#pragma unroll
            for (int m = 0; m < 4; ++m) { const int row = row0 + ai * HALF + m * 16;
                const float r = 1.0f / sqrtf(__hip_atomic_load(ss + row, __ATOMIC_RELAXED, __HIP_MEMORY_SCOPE_AGENT) * (1.0f / 1024.0f) + 1e-6f);
                float a[8];
#pragma unroll
                for (int n = 0; n < 2; ++n)
#pragma unroll
                    for (int j = 0; j < 4; ++j) a[4 * n + j] = silu_f(acc[ai][0][m][n][j] * r) * (acc[ai][1][m][n][j] * r);
                u32x4 w; w.x = cvt_pk_bf16(a[0], a[1]); w.y = cvt_pk_bf16(a[2], a[3]); w.z = cvt_pk_bf16(a[4], a[5]); w.w = cvt_pk_bf16(a[6], a[7]);
                *(u32x4*)((char*)H + img_off(row, col0, 44)) = w; }
    }
};
struct EpiDown {
    static constexpr bool PERM = true, AFTER_DRAIN = false;
    float* y; const unsigned char* ws;
    __device__ __forceinline__ void operator()(const f32x4 (&acc)[2][2][4][2], const Unit& u, int wr, int wc, int fr, int fq) const {
        const int row0 = u.pm * BM + wr * 64 + fr; const int col0 = u.pn * BM + wc * 32 + 8 * fq; const char* x1b = (const char*)(ws + EW_X1B);
#pragma unroll
        for (int ai = 0; ai < 2; ++ai)
#pragma unroll
            for (int m = 0; m < 4; ++m) { const int row = row0 + ai * HALF + m * 16; const size_t off = (size_t)row * 1024 + col0;
#pragma unroll
                for (int bj = 0; bj < 2; ++bj) { const u32x4 xb = *(const u32x4*)(x1b + img_off(row, col0 + bj * HALF, 16)); float* p = y + off + bj * HALF;
                    const f32x4 x0 = (f32x4){__builtin_bit_cast(float, xb.x << 16), __builtin_bit_cast(float, xb.x & 0xffff0000u), __builtin_bit_cast(float, xb.y << 16), __builtin_bit_cast(float, xb.y & 0xffff0000u)};
                    const f32x4 x1 = (f32x4){__builtin_bit_cast(float, xb.z << 16), __builtin_bit_cast(float, xb.z & 0xffff0000u), __builtin_bit_cast(float, xb.w << 16), __builtin_bit_cast(float, xb.w & 0xffff0000u)};
                    __builtin_nontemporal_store(acc[ai][bj][m][0] + x0, (f32x4*)p); __builtin_nontemporal_store(acc[ai][bj][m][1] + x1, (f32x4*)(p + 4)); } }
    }
};

template <class Epi, class Sched, bool ALIGN_EPI = false, bool SP2 = false>
__device__ __forceinline__ void gemm_phase(PG8_LAS unsigned char* lds, const Gemm g, const Sched& S, const Epi& E) {
    const int tid = threadIdx.x, wid = __builtin_amdgcn_readfirstlane(tid >> 6), lane = tid & 63, wr = wid >> 2, wc = wid & 3, fr = lane & 15, fq = lane >> 4;
    const int K = g.K, nt = K / BK;
    unsigned voffA[2], voffB[2];
#pragma unroll
    for (int i = 0; i < 2; ++i) { voffA[i] = (unsigned)(tid * 16 + i * 8192); voffB[i] = voffA[i]; }
    static_assert(Epi::PERM, "image layout: B images are written with the perm32 row order");
    const size_t kstep = (size_t)HTB;
    const size_t hstep = (size_t)HALF * K * 2;
    const size_t tstep = 2 * hstep;
    const unsigned ldsw = (unsigned)wid * 1024u;
    const int aoff = lds_byte(wr * 64 + fr, fq * 8), boff = lds_byte(wc * 32 + fr, fq * 8);
#define PG8_SA(b, h) (((b) * 2 + (h)) * HTB)
#define PG8_SB(b, h) ((4 + (b) * 2 + (h)) * HTB)
#define PG8_STAGE(bufoff, gbase, voff) do { _Pragma("unroll") for (int _i = 0; _i < 2; ++_i) \
        __builtin_amdgcn_global_load_lds((const unsigned*)((const char*)(gbase) + (voff)[_i]), (PG8_LAS unsigned*)(lds + (bufoff) + ldsw + _i * 8192), 16, 0, 0); } while (0)
#define PG8_LDA(dst, b, h) do { _Pragma("unroll") for (int m = 0; m < 4; ++m) _Pragma("unroll") for (int k = 0; k < 2; ++k) dst[m][k] = *(const PG8_LAS bf16x8*)(lds + PG8_SA(b, h) + aoff + m * 2048 + k * 1024); } while (0)
#define PG8_LDB(dst, b, h) do { _Pragma("unroll") for (int n = 0; n < 2; ++n) _Pragma("unroll") for (int k = 0; k < 2; ++k) dst[n][k] = *(const PG8_LAS bf16x8*)(lds + PG8_SB(b, h) + boff + n * 2048 + k * 1024); } while (0)
#define PG8_MMA(ai, bj, At, Bt) do { __builtin_amdgcn_s_setprio(1); _Pragma("unroll") for (int m = 0; m < 4; ++m) _Pragma("unroll") for (int n = 0; n < 2; ++n) _Pragma("unroll") for (int k = 0; k < 2; ++k) \
        acc[ai][bj][m][n] = __builtin_amdgcn_mfma_f32_16x16x32_bf16(Bt[n][k], At[m][k], acc[ai][bj][m][n], 0, 0, 0); __builtin_amdgcn_s_setprio(0); } while (0)
#define PG8_WAIT_V(n) asm volatile("s_waitcnt vmcnt(" #n ")" ::: "memory")
#define PG8_WAIT_L(n) asm volatile("s_waitcnt lgkmcnt(" #n ")" ::: "memory")
#define PG8_BAR __builtin_amdgcn_s_barrier()
#define PG8_SCHED __builtin_amdgcn_sched_barrier(0)
    Unit cur, nxt; int ui = 0;
    if (!S.next(0, cur)) return;
    f32x4 acc[2][2][4][2];
#pragma unroll
    for (int a = 0; a < 2; ++a)
#pragma unroll
        for (int b = 0; b < 2; ++b)
#pragma unroll
            for (int m = 0; m < 4; ++m)
#pragma unroll
                for (int n = 0; n < 2; ++n) acc[a][b][m][n] = (f32x4){0.f, 0.f, 0.f, 0.f};
    bf16x8 At[4][2], B0[2][2], B1[2][2];
    const char* cA = (const char*)g.A + (size_t)cur.pm * tstep; const char* cB = (const char*)g.Bt + (size_t)cur.pn * tstep;
    S.a_ready(cur);
    if constexpr (SP2) {
        PG8_STAGE(PG8_SB(0, 0), cB, voffB); PG8_STAGE(PG8_SB(0, 1), cB + hstep, voffB); PG8_STAGE(PG8_SA(0, 0), cA, voffA); PG8_STAGE(PG8_SA(0, 1), cA + hstep, voffA);
        if (wr == 1) PG8_BAR;
        PG8_WAIT_V(2); PG8_BAR;
        PG8_STAGE(PG8_SB(1, 0), cB + kstep, voffB); PG8_STAGE(PG8_SA(1, 0), cA + kstep, voffA); PG8_STAGE(PG8_SB(1, 1), cB + hstep + kstep, voffB);
        PG8_WAIT_V(6); PG8_BAR;
    } else {
        PG8_STAGE(PG8_SB(0, 0), cB, voffB); PG8_STAGE(PG8_SA(0, 0), cA, voffA); PG8_STAGE(PG8_SB(0, 1), cB + hstep, voffB); PG8_STAGE(PG8_SA(0, 1), cA + hstep, voffA);
        if (wr == 1) PG8_BAR;
        PG8_WAIT_V(4); PG8_BAR;
        PG8_STAGE(PG8_SB(1, 0), cB + kstep, voffB); PG8_STAGE(PG8_SA(1, 0), cA + kstep, voffA); PG8_STAGE(PG8_SB(1, 1), cB + hstep + kstep, voffB);
        PG8_WAIT_V(6); PG8_BAR;
    }
    for (;;) {
        const bool has_next = S.next(ui + 1, nxt);
        const char* nA = has_next ? (const char*)g.A + (size_t)nxt.pm * tstep : cA; const char* nB = has_next ? (const char*)g.Bt + (size_t)nxt.pn * tstep : cB;
        for (int t = 0; t < nt; t += 2) {
            const bool last = (t == nt - 2);
            const char* a1 = cA + (size_t)(t + 1) * kstep;
            const char* a2 = last ? nA : cA + (size_t)(t + 2) * kstep; const char* b2 = last ? nB : cB + (size_t)(t + 2) * kstep;
            const char* a3 = a2 + kstep; const char* b3 = b2 + kstep;
            if (last && has_next) S.a_ready(nxt);
            if constexpr (SP2) {
            PG8_LDB(B0, 0, 0); PG8_LDB(B1, 0, 1); PG8_SCHED; PG8_LDA(At, 0, 0); PG8_STAGE(PG8_SA(1, 1), a1 + hstep, voffA);
            PG8_WAIT_V(8); PG8_WAIT_L(0); PG8_BAR; PG8_MMA(0, 0, At, B0); PG8_MMA(0, 1, At, B1); PG8_BAR; PG8_SCHED;
            PG8_LDA(At, 0, 1); PG8_STAGE(PG8_SB(0, 0), b2, voffB); PG8_STAGE(PG8_SB(0, 1), b2 + hstep, voffB); PG8_STAGE(PG8_SA(0, 0), a2, voffA);
            PG8_WAIT_V(8); PG8_WAIT_L(0); PG8_BAR; PG8_MMA(1, 0, At, B0); PG8_MMA(1, 1, At, B1); PG8_BAR; PG8_SCHED;
            PG8_LDB(B0, 1, 0); PG8_LDB(B1, 1, 1); PG8_SCHED; PG8_LDA(At, 1, 0); PG8_STAGE(PG8_SA(0, 1), a2 + hstep, voffA);
            PG8_WAIT_V(8); PG8_WAIT_L(0); PG8_BAR; PG8_MMA(0, 0, At, B0); PG8_MMA(0, 1, At, B1); PG8_BAR; PG8_SCHED;
            PG8_LDA(At, 1, 1); PG8_STAGE(PG8_SB(1, 0), b3, voffB); PG8_STAGE(PG8_SB(1, 1), b3 + hstep, voffB); PG8_STAGE(PG8_SA(1, 0), a3, voffA);
            PG8_WAIT_V(8); PG8_WAIT_L(0); PG8_BAR; PG8_MMA(1, 0, At, B0); PG8_MMA(1, 1, At, B1); PG8_BAR; PG8_SCHED;
            } else {
            PG8_LDB(B0, 0, 0); PG8_SCHED; PG8_LDA(At, 0, 0); PG8_STAGE(PG8_SA(1, 1), a1 + hstep, voffA);
            PG8_WAIT_L(8); PG8_BAR; PG8_WAIT_L(0); PG8_MMA(0, 0, At, B0); PG8_BAR; PG8_SCHED;
            PG8_LDB(B1, 0, 1); PG8_STAGE(PG8_SB(0, 0), b2, voffB);
            PG8_BAR; PG8_WAIT_L(0); PG8_MMA(0, 1, At, B1); PG8_BAR;
            PG8_LDA(At, 0, 1); PG8_STAGE(PG8_SA(0, 0), a2, voffA);
            PG8_BAR; PG8_WAIT_L(0); PG8_MMA(1, 0, At, B0); PG8_BAR; PG8_SCHED;
            PG8_STAGE(PG8_SB(0, 1), b2 + hstep, voffB);
            PG8_WAIT_V(6); PG8_BAR; PG8_MMA(1, 1, At, B1); PG8_BAR;
            PG8_LDB(B0, 1, 0); PG8_SCHED; PG8_LDA(At, 1, 0); PG8_STAGE(PG8_SA(0, 1), a2 + hstep, voffA);
            PG8_WAIT_L(8); PG8_BAR; PG8_WAIT_L(0); PG8_MMA(0, 0, At, B0); PG8_BAR; PG8_SCHED;
            PG8_LDB(B1, 1, 1); PG8_STAGE(PG8_SB(1, 0), b3, voffB);
            PG8_BAR; PG8_WAIT_L(0); PG8_MMA(0, 1, At, B1); PG8_BAR;
            PG8_LDA(At, 1, 1); PG8_STAGE(PG8_SA(1, 0), a3, voffA);
            PG8_BAR; PG8_WAIT_L(0); PG8_MMA(1, 0, At, B0); PG8_BAR; PG8_SCHED;
            PG8_STAGE(PG8_SB(1, 1), b3 + hstep, voffB);
            PG8_WAIT_V(6); PG8_BAR; PG8_MMA(1, 1, At, B1); PG8_BAR;
            }
        }
        if constexpr (ALIGN_EPI) { if (wr == 0) PG8_BAR; }
        if constexpr (!Epi::AFTER_DRAIN) { E(acc, cur, wr, wc, fr, fq); S.done(cur); }
        if (!has_next) break;
#pragma unroll
        for (int a = 0; a < 2; ++a)
#pragma unroll
            for (int b = 0; b < 2; ++b)
#pragma unroll
                for (int m = 0; m < 4; ++m)
#pragma unroll
                    for (int n = 0; n < 2; ++n) acc[a][b][m][n] = (f32x4){0.f, 0.f, 0.f, 0.f};
        cur = nxt; cA = nA; cB = nB; ++ui;
        if constexpr (ALIGN_EPI) { if (wr == 1) PG8_BAR; }
    }
    PG8_WAIT_V(0);
    if constexpr (!ALIGN_EPI) { if (wr == 0) PG8_BAR; }
    PG8_BAR;
    if constexpr (Epi::AFTER_DRAIN) { E.fused(acc, cur, wr, wc, fr, fq, lds, wid, lane); S.done(cur); }
#undef PG8_SA
#undef PG8_SB
#undef PG8_STAGE
#undef PG8_LDA
#undef PG8_LDB
#undef PG8_MMA
#undef PG8_WAIT_V
#undef PG8_WAIT_L
#undef PG8_BAR
#undef PG8_SCHED
}
}
#ifndef PG8_SP2
#define PG8_SP2 true
#endif
#ifndef PG8_ALIGN
#define PG8_ALIGN true
#endif
#ifndef MK_N_LAUNCHES
#define MK_N_LAUNCHES 1
#endif
constexpr int NWAVES = 8;
constexpr int N_LAUNCHES = MK_N_LAUNCHES;
constexpr int PER_PHASE = 6;

constexpr int DM = 1024, SEQ = 2048, NBATCH = 8, MP = NBATCH * SEQ, NDEC = 128, TDEC = 4, MS = NDEC * TDEC, M = MP + MS;
constexpr int WA = 512, NIN = 2560, DFF = 2816, NGU = 2 * DFF, LB = 2048;
constexpr float EPS = 1e-6f;
constexpr size_t O_Y = 0, O_KP = (size_t)M * DM, O_VP = O_KP + (size_t)MP * 512, O_KS = O_VP + (size_t)MP * 512, O_VS = O_KS + (size_t)MS * 512, O_VC = O_VS + (size_t)MS * 512, O_END = O_VC + (size_t)MS * 512;
constexpr size_t MiB = 1u << 20;
constexpr size_t WS_CTL = 0, CTL_ZERO_BYTES = 1 * MiB;
constexpr size_t WS_WIN = 2 * MiB, WS_WO = 8 * MiB, WS_WGU = 10 * MiB, WS_WD = 22 * MiB, WS_WS = 28 * MiB;
constexpr size_t WS_XN = 32 * MiB, WS_U = 66 * MiB, WS_GV = 83 * MiB, WS_Q = 100 * MiB, WS_K = 117 * MiB, WS_V = 134 * MiB, WS_MIX = 152 * MiB, WS_X1B = 186 * MiB, WS_H = 220 * MiB, WS_END = 312 * MiB;
static_assert(WS_WIN + (size_t)NIN * DM * 2 <= WS_WO && WS_WGU + (size_t)NGU * DM * 2 <= WS_WD && WS_WD + (size_t)DM * DFF * 2 <= WS_WS && WS_XN + (size_t)M * DM * 2 <= WS_U && WS_U + (size_t)M * 512 * 2 <= WS_GV &&
              WS_MIX + (size_t)M * DM * 2 <= WS_X1B && WS_X1B + (size_t)M * DM * 2 <= WS_H && WS_H + (size_t)M * DFF * 2 <= WS_END, "d_ws map");
constexpr int CW_TMO = 0, CW_CODE = 1, CW_QUEUE = 64, CW_BAR = 4096, CW_ST1 = 16384, CW_ST2 = CW_ST1 + M, CW_SS = CW_ST2 + M, CW_END = CW_SS + M;
static_assert(CW_END * 4 <= (int)CTL_ZERO_BYTES, "CTL words inside the memset region");
static_assert(pg8::EW_U == WS_U && pg8::EW_GV == WS_GV && pg8::EW_Q == WS_Q && pg8::EW_K == WS_K && pg8::EW_V == WS_V && pg8::EW_X1B == WS_X1B && pg8::EW_H == WS_H && pg8::EC_ST1 == CW_ST1 && pg8::EC_ST2 == CW_ST2 && pg8::EC_SS == CW_SS && pg8::EO_KP == O_KP && pg8::EO_VP == O_VP && pg8::EO_KS == O_KS && pg8::EO_VS == O_VS && WS_CTL == 0, "epilogue constants match the maps");
constexpr int RING_OFF = 0, RING_BYTES = 131072;
constexpr int LDSCTL_OFF = RING_BYTES, MISC_OFF = LDSCTL_OFF + 320, RED_OFF = RING_BYTES + 1024;
constexpr int LDS_BYTES = 147456;
static_assert(RED_OFF + 4096 + 8192 <= LDS_BYTES, "LDS map");

#define GAS __attribute__((address_space(1)))
#define LAS __attribute__((address_space(3)))
typedef unsigned short bf16;
typedef unsigned v4u __attribute__((ext_vector_type(4)));
typedef unsigned v2u __attribute__((ext_vector_type(2)));
typedef float f32x4 __attribute__((ext_vector_type(4)));
typedef float f32x16 __attribute__((ext_vector_type(16)));
typedef short bf16x8 __attribute__((ext_vector_type(8)));
typedef short v4i16_t __attribute__((ext_vector_type(4)));
typedef GAS unsigned gu32;
#define RLX_AGENT __ATOMIC_RELAXED, __HIP_MEMORY_SCOPE_AGENT
#define LDS_WAIT() asm volatile("s_waitcnt lgkmcnt(0)" ::: "memory")
#define VM_WAIT() asm volatile("s_waitcnt vmcnt(0)" ::: "memory")
__device__ __forceinline__ unsigned f2bf(float f) { unsigned u = __builtin_bit_cast(unsigned, f); return (u + 0x7fffu + ((u >> 16) & 1u)) >> 16; }
__device__ __forceinline__ unsigned pk2(float lo, float hi) { return pg8::cvt_pk_bf16(lo, hi); }
__device__ __forceinline__ float bf_lo(unsigned w) { return __builtin_bit_cast(float, w << 16); }
__device__ __forceinline__ float bf_hi(unsigned w) { return __builtin_bit_cast(float, w & 0xffff0000u); }
__device__ __forceinline__ float bf2f(bf16 b) { return __builtin_bit_cast(float, (unsigned)b << 16); }

#define XB_TMO      128
#define XB_XCNT(j)  (256  + 64 * (j))
#define XB_XSUB(j)  (1280 + 64 * (j))
#define XB_XGEN(j)  (2304 + 64 * (j))
#define XB_TOP      3328
#define XB_TOPGEN   3392
#define XCD_BAR_WORDS 3456
#define XB_SPIN_CAP (1u << 18)

__device__ __forceinline__ unsigned xb_ld(unsigned* p)              { return __hip_atomic_load(p, __ATOMIC_RELAXED, __HIP_MEMORY_SCOPE_AGENT); }
__device__ __forceinline__ unsigned xb_add(unsigned* p, unsigned v) { return __hip_atomic_fetch_add(p, v, __ATOMIC_RELAXED, __HIP_MEMORY_SCOPE_AGENT); }
__device__ __forceinline__ unsigned xb_xcc_id() { return (unsigned)__builtin_amdgcn_s_getreg((3 << 11) | 20) & 0xFu; }
#define XB_SPIN(cond, bar) do { unsigned _sp = 0; while (cond) { __builtin_amdgcn_s_sleep(1); \
    if ((++_sp & 255u) == 0u) { if (xb_ld(&(bar)[XB_TMO])) break; if (_sp > XB_SPIN_CAP) { atomicAdd(&(bar)[XB_TMO], 1u); break; } } } } while (0)

struct XcdBarrier {
    unsigned* bar; unsigned x;
    volatile LAS unsigned* st;
};

__device__ __forceinline__ XcdBarrier xcd_barrier_post(unsigned* bar, volatile LAS unsigned* st) {
    XcdBarrier b; b.bar = bar; b.x = xb_xcc_id(); b.st = st;
    if (threadIdx.x == 0) (void)xb_add(&bar[XB_XCNT(b.x)], 1u);
    return b;
}
__device__ __forceinline__ void xcd_barrier_complete(unsigned* bar, unsigned x, unsigned& nloc, unsigned& nx) {
    const unsigned G = gridDim.x * gridDim.y * gridDim.z;
    unsigned sum, cnt, mine, sp = 0u;
    for (;;) {
        sum = 0u; cnt = 0u; mine = 0u;
#pragma unroll
        for (unsigned j = 0; j < 16; ++j) { const unsigned c = xb_ld(&bar[XB_XCNT(j)]); sum += c; cnt += (c > 0u) ? 1u : 0u; mine = (j == x) ? c : mine; }
        if (sum == G) break;
        __builtin_amdgcn_s_sleep(1);
        if ((++sp & 255u) == 0u) { if (xb_ld(&bar[XB_TMO])) break; if (sp > XB_SPIN_CAP) { atomicAdd(&bar[XB_TMO], 1u); break; } }
    }
    nloc = mine > 0u ? mine : 1u; nx = cnt > 0u ? cnt : 1u;
}

__device__ __forceinline__ void xcd_barrier(const XcdBarrier& b) {
    asm volatile("s_waitcnt vmcnt(0)" ::: "memory");
    __syncthreads();
    if (threadIdx.x == 0) {
        unsigned* bar = b.bar;
        __builtin_amdgcn_s_waitcnt(0);
        unsigned nloc = b.st[0], nx = b.st[1];
        if (nloc == 0u) { xcd_barrier_complete(bar, b.x, nloc, nx); b.st[0] = nloc; b.st[1] = nx; }
        const unsigned old = xb_add(&bar[XB_XSUB(b.x)], 1u);
        const unsigned gen = old / nloc;
        if (old + 1u == (gen + 1u) * nloc) {
            __builtin_amdgcn_fence(__ATOMIC_RELEASE, "agent");
            asm volatile("s_waitcnt vmcnt(0)" ::: "memory");
            const unsigned og = xb_add(&bar[XB_TOP], 1u);
            const unsigned tg = og / nx;
            if (og + 1u == (tg + 1u) * nx) xb_add(&bar[XB_TOPGEN], 1u);
            else XB_SPIN(xb_ld(&bar[XB_TOPGEN]) == tg, bar);
            __builtin_amdgcn_fence(__ATOMIC_ACQUIRE, "agent");
            xb_add(&bar[XB_XGEN(b.x)], 1u);
            asm volatile("s_waitcnt vmcnt(0)" ::: "memory");
        } else {
            XB_SPIN(xb_ld(&bar[XB_XGEN(b.x)]) == gen, bar);
            __builtin_amdgcn_fence(__ATOMIC_ACQUIRE, "agent");
            asm volatile("s_waitcnt vmcnt(0)" ::: "memory");
        }
    }
    __syncthreads();
}
struct Args { const float* in[19]; float* out; unsigned char* ws; int ph_lo, ph_hi; };
struct Frame {
    LAS unsigned char* lds;
    volatile LAS unsigned* MISC;
    gu32* ctl;
    int tid, lane, wave;
    int vcu, G;
    unsigned char* ws; float* out;
};

__device__ __forceinline__ float wave_sum(float v) {
#pragma unroll
    for (int o = 1; o < 64; o <<= 1) v += __shfl_xor(v, o);
    return v;
}
__device__ __forceinline__ float wave_max(float v) {
#pragma unroll
    for (int o = 1; o < 64; o <<= 1) v = fmaxf(v, __shfl_xor(v, o));
    return v;
}
__device__ __forceinline__ void p0_transpose_item(const float* W, int K, int N, bf16* WT, int drow0, const float* kscale, LAS float* scr, int k0, int n0, int lane) {
#pragma unroll
    for (int i = 0; i < 32; ++i) { const int kk = 2 * i + (lane >> 5); float w = W[(size_t)(k0 + kk) * N + n0 + (lane & 31)]; if (kscale) w *= kscale[k0 + kk]; scr[kk * 33 + (lane & 31)] = w; }
    LDS_WAIT(); asm volatile("" ::: "memory");
    const int c = lane & 7;
#pragma unroll
    for (int j = 0; j < 4; ++j) { const int n = (lane >> 3) + 8 * j; const LAS float* s = scr + (8 * c) * 33 + n;
        v4u o; o.x = pk2(s[0 * 33], s[1 * 33]); o.y = pk2(s[2 * 33], s[3 * 33]); o.z = pk2(s[4 * 33], s[5 * 33]); o.w = pk2(s[6 * 33], s[7 * 33]);
        *(GAS v4u*)((GAS char*)WT + pg8::img_off_b(drow0 + n, k0 + 8 * c, K >> 6)) = o; }
    LDS_WAIT(); asm volatile("" ::: "memory");
}
__device__ __forceinline__ int win_drow(int n0) { const int sec = n0 >> 9; if (sec < 2) return n0; const int cs = n0 & 511, head = cs >> 6, dh = (cs >> 5) & 1; return 256 * (2 * sec + (head >> 2)) + 128 * dh + 32 * (head & 3); }
__device__ __forceinline__ void rms_row2_to_bf16(const float* xrow0, const float* xrow1, const float* g, bf16* obase, int orow, int lane) {
    const GAS f32x4* xr0 = (const GAS f32x4*)xrow0 + lane; const GAS f32x4* xr1 = (const GAS f32x4*)xrow1 + lane; const GAS f32x4* gr = (const GAS f32x4*)g + lane;
    f32x4 v0[4], v1[4]; float s0 = 0.f, s1 = 0.f;
#pragma unroll
    for (int j = 0; j < 4; ++j) { v0[j] = xr0[64 * j]; v1[j] = xr1[64 * j]; }
#pragma unroll
    for (int j = 0; j < 4; ++j) { s0 += (v0[j].x * v0[j].x + v0[j].y * v0[j].y) + (v0[j].z * v0[j].z + v0[j].w * v0[j].w); s1 += (v1[j].x * v1[j].x + v1[j].y * v1[j].y) + (v1[j].z * v1[j].z + v1[j].w * v1[j].w); }
    const float r0 = 1.f / sqrtf(wave_sum(s0) * (1.f / DM) + EPS), r1 = 1.f / sqrtf(wave_sum(s1) * (1.f / DM) + EPS);
#pragma unroll
    for (int j = 0; j < 4; ++j) { const f32x4 gg = gr[64 * j]; v2u o;
        o.x = pk2(v0[j].x * r0 * gg.x, v0[j].y * r0 * gg.y); o.y = pk2(v0[j].z * r0 * gg.z, v0[j].w * r0 * gg.w); *(GAS v2u*)((GAS char*)obase + pg8::img_off(orow, 4 * lane + 256 * j, DM / 64)) = o;
        o.x = pk2(v1[j].x * r1 * gg.x, v1[j].y * r1 * gg.y); o.y = pk2(v1[j].z * r1 * gg.z, v1[j].w * r1 * gg.w); *(GAS v2u*)((GAS char*)obase + pg8::img_off(orow + 1, 4 * lane + 256 * j, DM / 64)) = o; }
}
constexpr int I_IN = (DM / 64) * (NIN / 32), I_O = (DM / 64) * (DM / 32), I_G = (DM / 64) * (DFF / 32), I_D = (DFF / 64) * (DM / 32), I_LATE = I_O + 2 * I_G + I_D;
__device__ __forceinline__ void p0_late_item(Frame& F, const Args& A, LAS float* scr, int r) {
    if (r < I_O) { const int nblk = DM / 32, kb = r / nblk, nb = r % nblk; p0_transpose_item(A.in[14], DM, DM, ((bf16*)(F.ws + WS_WO)), 32 * nb, nullptr, scr, 64 * kb, 32 * nb, F.lane); return; } r -= I_O;
    if (r < 2 * I_G) { const bool up = r >= I_G; if (up) r -= I_G; const int nblk = DFF / 32, kb = r / nblk, nb = r % nblk, n0 = 32 * nb;
        p0_transpose_item(up ? A.in[17] : A.in[16], DM, DFF, ((bf16*)(F.ws + WS_WGU)), 256 * (n0 >> 7) + (up ? 128 : 0) + (n0 & 127), A.in[15], scr, 64 * kb, n0, F.lane); return; } r -= 2 * I_G;
    { const int nblk = DM / 32, kb = r / nblk, nb = r % nblk; p0_transpose_item(A.in[18], DFF, DM, ((bf16*)(F.ws + WS_WD)), 32 * nb, nullptr, scr, 64 * kb, 32 * nb, F.lane); }
}
__device__ __forceinline__ void p0_prologue(Frame& F, const Args& A) {
    LAS float* scr = (LAS float*)(F.lds + RING_OFF + F.wave * 16384);
    const int gw = F.vcu * NWAVES + F.wave, NGW = F.G * NWAVES;
    for (int r = gw; r < I_IN; r += NGW) { const int nblk = NIN / 32, kb = r / nblk, nb = r % nblk; p0_transpose_item(A.in[5], DM, NIN, ((bf16*)(F.ws + WS_WIN)), win_drow(32 * nb), nullptr, scr, 64 * kb, 32 * nb, F.lane); }
    for (int r = gw; r < I_LATE; r += NGW) p0_late_item(F, A, scr, r);
    for (int idx = gw; idx < 8 * 128; idx += NGW) { const int i = idx & 127;
#pragma unroll
        for (int q = 0; q < 2; ++q) { const int jj = F.lane + 64 * q; ((bf16*)(F.ws + WS_WS))[(size_t)idx * 128 + jj] = (jj <= i) ? (bf16)f2bf(A.in[8][(size_t)idx * 128 + jj]) : (bf16)0; } }
    for (int m = 2 * gw; m < M; m += 2 * NGW) {
        const float* x0 = (m < MP) ? A.in[0] + (size_t)m * DM : A.in[1] + (size_t)(m - MP) * DM; const float* x1 = (m + 1 < MP) ? A.in[0] + (size_t)(m + 1) * DM : A.in[1] + (size_t)(m + 1 - MP) * DM;
        rms_row2_to_bf16(x0, x1, A.in[4], ((bf16*)(F.ws + WS_XN)), m, F.lane); }
}
__device__ __forceinline__ float wgt(int delta, int qpos) {
    const int w = (delta <= 128 ? 1 : 0) + ((((delta & 3) == 0) && delta <= 512) ? 1 : 0) + ((((delta & 15) == 0) && delta <= 2048) ? 1 : 0);
    return ((unsigned)delta <= (unsigned)qpos) ? (float)w : 0.f;
}
__device__ __forceinline__ v4i16_t vtr(const LAS unsigned char* p) { return __builtin_amdgcn_ds_read_tr16_b64_v4i16((LAS v4i16_t*)p); }
__device__ __forceinline__ bf16x8 cat8(v4i16_t a, v4i16_t b) { return (bf16x8){a[0], a[1], a[2], a[3], b[0], b[1], b[2], b[3]}; }

struct KSet { bf16x8 kf[4]; };
__device__ __forceinline__ void a_tile_desc(int tt, int P0, int& kbase, int& stride) {
    if (tt < 6) { kbase = P0 - 2048 + 256 * tt; stride = 8; } else if (tt < 9) { kbase = P0 - 512 + 128 * (tt - 6); stride = 4; } else { kbase = P0 - 128 + 32 * (tt - 9); stride = 1; }
}
__device__ __forceinline__ void a_kstore(const v4u (&kv)[4], LAS unsigned char* slot, int lane) {
#pragma unroll
    for (int it = 0; it < 4; ++it) { const int row = (lane >> 3) + 8 * it; *(LAS v4u*)(slot + row * 128 + 16 * ((lane & 7) ^ ((row >> 1) & 7))) = kv[it]; }
}
__device__ __forceinline__ void a_kfrag(KSet& T, const LAS unsigned char* slot, int lane) {
    const int i = lane & 31, hi = lane >> 5, sw = (i >> 1) & 7;
#pragma unroll
    for (int kk = 0; kk < 4; ++kk) T.kf[kk] = *(const LAS bf16x8*)(slot + i * 128 + 16 * ((2 * kk + hi) ^ sw));
}
__device__ __forceinline__ void a_kvload(v4u (&kv)[4], v4u (&vv)[4], const bf16* Kh, const bf16* Vh, int tt, int P0, int lane) {
    int kbase, stride; a_tile_desc(tt > 20 ? 20 : tt, P0, kbase, stride);
    const int kp0 = kbase + stride * (lane >> 3), cb = 16 * (lane & 7);
#pragma unroll
    for (int it = 0; it < 4; ++it) { int kp = kp0 + 8 * stride * it; kp = kp < 0 ? 0 : (kp > SEQ - 1 ? SEQ - 1 : kp); const unsigned off = (unsigned)kp * 1024u + (unsigned)cb;
        kv[it] = *(const v4u*)((const char*)Kh + (size_t)off); vv[it] = *(const v4u*)((const char*)Vh + (size_t)off); }
}
__device__ __forceinline__ void a_vstore(const v4u (&vv)[4], LAS unsigned char* slot, int lane) {
#pragma unroll
    for (int it = 0; it < 4; ++it) *(LAS v4u*)(slot + ((lane >> 3) + 8 * it) * 128 + (lane & 7) * 16) = vv[it];
}
__device__ __forceinline__ f32x16 a_qk(const KSet& T, const bf16x8 (&qf)[4], float negb) {
    f32x16 s;
#pragma unroll
    for (int r = 0; r < 16; ++r) s[r] = negb;
#pragma unroll
    for (int kk = 0; kk < 4; ++kk) s = __builtin_amdgcn_mfma_f32_32x32x16_bf16(T.kf[kk], qf[kk], s, 0, 0, 0);
    return s;
}
template <int RANGE> __device__ __forceinline__ void a_periodic(float (&wp)[16], int P0, int qpos, int lane) {
    constexpr int ST = RANGE == 3 ? 8 : (RANGE == 2 ? 4 : 1);
    const int kb0 = RANGE == 3 ? P0 - 2048 : (RANGE == 2 ? P0 - 512 : P0 - 128);
    const int d0 = qpos - kb0 - ST * 4 * (lane >> 5);
#pragma unroll
    for (int r = 0; r < 16; ++r) { const int delta = d0 - ST * ((r & 3) + 8 * (r >> 2)); wp[r] = (RANGE == 1 ? (((delta & 3) == 0) ? 1.f : 0.f) : 0.f) + (((delta & 15) == 0) ? 1.f : 0.f); }
}
template <int RANGE>
__device__ __forceinline__ void a_softmax(f32x16 s, int tt, int P0, int qpos, int lane, const float (&wp)[16], bf16x8& pf0, bf16x8& pf1, float& lsum) {
    constexpr int ST = RANGE == 3 ? 8 : (RANGE == 2 ? 4 : 1);
    int kbase, stride; a_tile_desc(tt, P0, kbase, stride);
    const int hi = lane >> 5;
    const int d0 = qpos - kbase - ST * 4 * hi;
    const int lim3 = qpos < 2048 ? qpos : 2048;
    float ps = 0.f;
#pragma unroll
    for (int r = 0; r < 16; ++r) { const int delta = d0 - ST * ((r & 3) + 8 * (r >> 2)); float w;
        if (RANGE == 1) w = ((unsigned)delta <= (unsigned)qpos) ? wp[r] + (delta <= 128 ? 1.f : 0.f) : 0.f;
        else if (RANGE == 2) w = (delta <= qpos) ? wp[r] + (delta <= 512 ? 1.f : 0.f) : 0.f;
        else w = (delta <= lim3) ? wp[r] : 0.f;
        const float p = w * __builtin_amdgcn_exp2f(s[r]); ps += p; s[r] = p; }
    lsum += ps;
    v4u pa, pb; pa.x = pk2(s[0], s[1]); pa.y = pk2(s[2], s[3]); pa.z = pk2(s[4], s[5]); pa.w = pk2(s[6], s[7]); pb.x = pk2(s[8], s[9]); pb.y = pk2(s[10], s[11]); pb.z = pk2(s[12], s[13]); pb.w = pk2(s[14], s[15]);
    pf0 = __builtin_bit_cast(bf16x8, pa); pf1 = __builtin_bit_cast(bf16x8, pb);
}
__device__ __forceinline__ void a_pv(const bf16x8 pf0, const bf16x8 pf1, int lane, const LAS unsigned char* slot, f32x16& o0, f32x16& o1) {
    const int ii = lane & 15, hi = lane >> 5;
    const LAS unsigned char* vb = slot + (4 * hi + (ii >> 2)) * 128 + (16 * ((lane >> 4) & 1) + 4 * (ii & 3)) * 2;
    { const bf16x8 v00 = cat8(vtr(vb), vtr(vb + 1024)), v01 = cat8(vtr(vb + 2048), vtr(vb + 2048 + 1024));
      const bf16x8 v10 = cat8(vtr(vb + 64), vtr(vb + 64 + 1024)), v11 = cat8(vtr(vb + 64 + 2048), vtr(vb + 64 + 2048 + 1024));
      o0 = __builtin_amdgcn_mfma_f32_32x32x16_bf16(v00, pf0, o0, 0, 0, 0); o0 = __builtin_amdgcn_mfma_f32_32x32x16_bf16(v01, pf1, o0, 0, 0, 0);
      o1 = __builtin_amdgcn_mfma_f32_32x32x16_bf16(v10, pf0, o1, 0, 0, 0); o1 = __builtin_amdgcn_mfma_f32_32x32x16_bf16(v11, pf1, o1, 0, 0, 0); }
}
struct ASeq { int t, n1, n2, n3, ord, f2, f1; };
__device__ __forceinline__ int a_next(int tt, int f2, int f1) { int u = tt + 1; if (u == 6) u = 6 + f2; if (u == 9) u = 9 + f1; return u; }
__device__ __forceinline__ void a_step(ASeq& Q, v4u (&kv)[4], v4u (&vv)[4], f32x16& s_cur, int& wrange, float (&wp)[16], const bf16* Kh, const bf16* Vh, int P0, int qpos, int lane, const bf16x8 (&qf)[4], float negb,
                                       LAS unsigned char* vt, f32x16& o0, f32x16& o1, float& lsum) {
    LAS unsigned char* kslot = vt + 8192 + ((Q.ord + 1) & 1) * 4096;
    a_kstore(kv, kslot, lane); a_vstore(vv, vt + ((Q.ord + 1) & 1) * 4096, lane);
    a_kvload(kv, vv, Kh, Vh, Q.n2, P0, lane);
    f32x16 s_next; { KSet KA; a_kfrag(KA, kslot, lane); s_next = a_qk(KA, qf, negb); }
    const int range = Q.t < 6 ? 3 : (Q.t < 9 ? 2 : 1);
    if (range != wrange) { wrange = range; if (range == 3) a_periodic<3>(wp, P0, qpos, lane); else if (range == 2) a_periodic<2>(wp, P0, qpos, lane); else a_periodic<1>(wp, P0, qpos, lane); }
    bf16x8 pf0, pf1;
    if (range == 3) a_softmax<3>(s_cur, Q.t, P0, qpos, lane, wp, pf0, pf1, lsum);
    else if (range == 2) a_softmax<2>(s_cur, Q.t, P0, qpos, lane, wp, pf0, pf1, lsum);
    else a_softmax<1>(s_cur, Q.t, P0, qpos, lane, wp, pf0, pf1, lsum);
    a_pv(pf0, pf1, lane, vt + (Q.ord & 1) * 4096, o0, o1);
    s_cur = s_next;
    Q.t = Q.n1; Q.n1 = Q.n2; Q.n2 = Q.n3; Q.n3 = a_next(Q.n3, Q.f2, Q.f1); ++Q.ord;
}
__device__ __forceinline__ void unitA(Frame& F, const Args& A, int ua, float negb) {
    const int b = ua >> 6, g = (ua >> 3) & 7, r = ua & 7;
    int lane = (int)threadIdx.x & 63; asm volatile("" : "+v"(lane));
    const int h = F.wave, i = lane & 31, hi = lane >> 5;
    const int P0 = 256 * g + r, qpos = P0 + 8 * i;
    const size_t rowb = (size_t)b * SEQ;
    const bf16* Qp = ((bf16*)(F.ws + WS_Q)) + (rowb + qpos) * 512 + 64 * h + 8 * hi;
    bf16x8 qf[4];
#pragma unroll
    for (int kk = 0; kk < 4; ++kk) qf[kk] = *(const bf16x8*)(Qp + 16 * kk);
    const bf16* Kh = ((bf16*)(F.ws + WS_K)) + rowb * 512 + 64 * h; const bf16* Vh = ((bf16*)(F.ws + WS_V)) + rowb * 512 + 64 * h;
    LAS unsigned char* vt = F.lds + RING_OFF + h * 16384;
    f32x16 o0, o1;
#pragma unroll
    for (int q = 0; q < 16; ++q) { o0[q] = 0.f; o1[q] = 0.f; }
    float lsum = 0.f;
    int f3 = 0, f2 = 0, f1 = 0;
    while (f3 < 6 && P0 - 2048 + 256 * f3 + 248 < 0) ++f3;
    while (f2 < 3 && P0 - 512 + 128 * f2 + 124 < 0) ++f2;
    while (f1 < 12 && P0 - 128 + 32 * f1 + 31 < 0) ++f1;
    ASeq Q; Q.f2 = f2; Q.f1 = f1; Q.ord = 0;
    Q.t = f3 < 6 ? f3 : (f2 < 3 ? 6 + f2 : 9 + f1); Q.n1 = a_next(Q.t, f2, f1); Q.n2 = a_next(Q.n1, f2, f1); Q.n3 = a_next(Q.n2, f2, f1);
    v4u kv[4], vv[4];
    a_kvload(kv, vv, Kh, Vh, Q.t, P0, lane);
    a_kstore(kv, vt + 8192, lane); a_vstore(vv, vt, lane);
    a_kvload(kv, vv, Kh, Vh, Q.n1, P0, lane);
    f32x16 s_cur; { KSet K0; a_kfrag(K0, vt + 8192, lane); s_cur = a_qk(K0, qf, negb); }
    const int ntile = (6 - f3) + (3 - f2) + (12 - f1);
    int wrange = 0; float wp[16];
#pragma unroll
    for (int q = 0; q < 16; ++q) wp[q] = 0.f;
#pragma unroll 1
    for (int k = 0; k < ntile; ++k) a_step(Q, kv, vv, s_cur, wrange, wp, Kh, Vh, P0, qpos, lane, qf, negb, vt, o0, o1, lsum);
    const float lt = lsum + __shfl_xor(lsum, 32), inv = 1.0f / lt;
    float ssq = 0.f;
#pragma unroll
    for (int q = 0; q < 16; ++q) { o0[q] *= inv; o1[q] *= inv; ssq += o0[q] * o0[q] + o1[q] * o1[q]; }
    ssq += __shfl_xor(ssq, 32);
    LAS float* RED = (LAS float*)(F.lds + RED_OFF);
    if (hi == 0) RED[h * 32 + i] = ssq;
    __syncthreads();
    float tot = 0.f;
#pragma unroll
    for (int w = 0; w < 8; ++w) tot += RED[w * 32 + i];
    const float rr = 1.0f / sqrtf(tot * (1.0f / 512.0f) + EPS);
    char* mixb = (char*)(F.ws + WS_MIX); const int mrow = (int)rowb + qpos;
#pragma unroll
    for (int db = 0; db < 2; ++db)
#pragma unroll
        for (int rq = 0; rq < 4; ++rq) { const int d0 = 32 * db + 8 * rq + 4 * hi; const f32x4 gg = *(const f32x4*)(A.in[13] + 64 * h + d0);
            const float a0 = (db ? o1[4 * rq] : o0[4 * rq]) * rr * gg.x, a1 = (db ? o1[4 * rq + 1] : o0[4 * rq + 1]) * rr * gg.y, a2 = (db ? o1[4 * rq + 2] : o0[4 * rq + 2]) * rr * gg.z, a3 = (db ? o1[4 * rq + 3] : o0[4 * rq + 3]) * rr * gg.w;
            v2u w; w.x = pk2(a0, a1); w.y = pk2(a2, a3); *(v2u*)(mixb + pg8::img_off(mrow, 512 + 64 * h + d0, DM / 64)) = w; }
    __syncthreads();
}

__device__ __forceinline__ void unitB(Frame& F, const Args& A, int ub) {
    int lane = (int)threadIdx.x & 63; asm volatile("" : "+v"(lane));
    const int h = F.wave, il = lane & 31, hi = lane >> 5;
    const size_t R0 = (size_t)ub * 128;
    LAS unsigned char* vn = F.lds + RING_OFF + h * 16384;
    { const int jl = lane >> 3, ch = lane & 7;
      f32x4 lg0 = *(const f32x4*)(A.in[6] + 64 * h + 8 * ch), lg1 = *(const f32x4*)(A.in[6] + 64 * h + 8 * ch + 4), lb0 = *(const f32x4*)(A.in[7] + 64 * h + 8 * ch), lb1 = *(const f32x4*)(A.in[7] + 64 * h + 8 * ch + 4);
#pragma unroll 4
      for (int it = 0; it < 16; ++it) { const int j = jl + 8 * it; const size_t row = R0 + j;
          const v4u gv = *(const v4u*)(((bf16*)(F.ws + WS_GV)) + row * 512 + 64 * h + 8 * ch);
          const float mu = __hip_atomic_load(((float*)F.ws + CW_ST1) + row, RLX_AGENT) * (1.0f / 512.0f), var = __hip_atomic_load(((float*)F.ws + CW_ST2) + row, RLX_AGENT) * (1.0f / 512.0f) - mu * mu, rstd = 1.0f / sqrtf(var + EPS);
          v4u o;
          o.x = pk2((bf_lo(gv.x) - mu) * rstd * lg0.x + lb0.x, (bf_hi(gv.x) - mu) * rstd * lg0.y + lb0.y); o.y = pk2((bf_lo(gv.y) - mu) * rstd * lg0.z + lb0.z, (bf_hi(gv.y) - mu) * rstd * lg0.w + lb0.w);
          o.z = pk2((bf_lo(gv.z) - mu) * rstd * lg1.x + lb1.x, (bf_hi(gv.z) - mu) * rstd * lg1.y + lb1.y); o.w = pk2((bf_lo(gv.w) - mu) * rstd * lg1.z + lb1.z, (bf_hi(gv.w) - mu) * rstd * lg1.w + lb1.w);
          *(LAS v4u*)(vn + j * 128 + ch * 16) = o; } }
    f32x16 acc[4][2];
#pragma unroll
    for (int ib = 0; ib < 4; ++ib)
#pragma unroll
        for (int db = 0; db < 2; ++db)
#pragma unroll
            for (int q = 0; q < 16; ++q) acc[ib][db][q] = 0.f;
    const int ii = lane & 15;
    const LAS unsigned char* vb = vn + (8 * hi + (ii >> 2)) * 128 + (16 * ((lane >> 4) & 1) + 4 * (ii & 3)) * 2;
    const bf16* Wh = ((bf16*)(F.ws + WS_WS)) + (size_t)h * 128 * 128 + (size_t)il * 128 + 8 * hi;
#pragma unroll
    for (int ib = 0; ib < 4; ++ib) {
        bf16x8 wf[8];
#pragma unroll
        for (int kk = 0; kk < 8; ++kk) if (kk < 2 * ib + 2) wf[kk] = *(const bf16x8*)(Wh + (size_t)ib * 32 * 128 + 16 * kk);
#pragma unroll
        for (int kk = 0; kk < 8; ++kk) if (kk < 2 * ib + 2) {
            const bf16x8 a0 = cat8(vtr(vb + kk * 2048), vtr(vb + kk * 2048 + 512)), a1 = cat8(vtr(vb + kk * 2048 + 64), vtr(vb + kk * 2048 + 64 + 512));
            acc[ib][0] = __builtin_amdgcn_mfma_f32_32x32x16_bf16(a0, wf[kk], acc[ib][0], 0, 0, 0); acc[ib][1] = __builtin_amdgcn_mfma_f32_32x32x16_bf16(a1, wf[kk], acc[ib][1], 0, 0, 0); }
        __builtin_amdgcn_sched_barrier(0);
    }
    LAS float* RED = (LAS float*)(F.lds + RED_OFF);
#pragma unroll
    for (int ib = 0; ib < 4; ++ib) { const size_t row = R0 + 32 * ib + il; const float bsi = A.in[9][h * 128 + 32 * ib + il]; float ssq = 0.f;
#pragma unroll
        for (int db = 0; db < 2; ++db)
#pragma unroll
            for (int rq = 0; rq < 4; ++rq) { const int d0 = 32 * db + 8 * rq + 4 * hi; const v2u uu = *(const v2u*)(((bf16*)(F.ws + WS_U)) + row * 512 + 64 * h + d0);
                float a0 = bf_lo(uu.x) * (acc[ib][db][4 * rq] + bsi), a1 = bf_hi(uu.x) * (acc[ib][db][4 * rq + 1] + bsi), a2 = bf_lo(uu.y) * (acc[ib][db][4 * rq + 2] + bsi), a3 = bf_hi(uu.y) * (acc[ib][db][4 * rq + 3] + bsi);
                acc[ib][db][4 * rq] = a0; acc[ib][db][4 * rq + 1] = a1; acc[ib][db][4 * rq + 2] = a2; acc[ib][db][4 * rq + 3] = a3; ssq += (a0 * a0 + a1 * a1) + (a2 * a2 + a3 * a3); }
        ssq += __shfl_xor(ssq, 32);
        if (hi == 0) RED[h * 128 + 32 * ib + il] = ssq; }
    __syncthreads();
#pragma unroll
    for (int ib = 0; ib < 4; ++ib) { const size_t row = R0 + 32 * ib + il; float tot = 0.f;
#pragma unroll
        for (int w = 0; w < 8; ++w) tot += RED[w * 128 + 32 * ib + il];
        const float rr = 1.0f / sqrtf(tot * (1.0f / 512.0f) + EPS);
        char* mixb = (char*)(F.ws + WS_MIX);
#pragma unroll
        for (int db = 0; db < 2; ++db)
#pragma unroll
            for (int rq = 0; rq < 4; ++rq) { const int d0 = 32 * db + 8 * rq + 4 * hi; const f32x4 gg = *(const f32x4*)(A.in[12] + 64 * h + d0);
                v2u w; w.x = pk2(acc[ib][db][4 * rq] * rr * gg.x, acc[ib][db][4 * rq + 1] * rr * gg.y); w.y = pk2(acc[ib][db][4 * rq + 2] * rr * gg.z, acc[ib][db][4 * rq + 3] * rr * gg.w); *(v2u*)(mixb + pg8::img_off((int)row, 64 * h + d0, DM / 64)) = w; } }
    __syncthreads();
}

template <int CTRL> __device__ __forceinline__ float dppf(float x) { return __builtin_bit_cast(float, __builtin_amdgcn_mov_dpp(__builtin_bit_cast(int, x), CTRL, 0xf, 0xf, true)); }
__device__ __forceinline__ float row16_sum(float v) { v += dppf<0xB1>(v); v += dppf<0x4E>(v); v += dppf<0x141>(v); v += dppf<0x128>(v); return v; }
__device__ __forceinline__ float dot4(f32x4 a, f32x4 b) { return (a.x * b.x + a.y * b.y) + (a.z * b.z + a.w * b.w); }
struct CState { f32x4 a[4]; float l[4]; };
__device__ __forceinline__ void c_row_t(const f32x4 k, const f32x4 v, int delta, const f32x4 qa, float negb, f32x4& a, float& l) {
    const float w = wgt(delta, 1 << 30);
    const float d = row16_sum(dot4(k, qa));
    const float p = w * __builtin_amdgcn_exp2f(d + negb);
    l += p; a += v * p;
}
struct CBuf { f32x4 k[8], v[8]; };
__device__ __forceinline__ void c_issue(CBuf& B, const float* kbase, const float* vbase, long rstride, int off) {
#pragma unroll
    for (int q = 0; q < 8; ++q) { B.k[q] = __builtin_nontemporal_load((const f32x4*)(kbase + (long)q * rstride + off)); B.v[q] = __builtin_nontemporal_load((const f32x4*)(vbase + (long)q * rstride + off)); }
}
__device__ __forceinline__ void c_consume(const CBuf& B, int delta0, int dstep, int tsel, const LAS float* qs, int off, float negb, CState& S) {
#pragma unroll
    for (int t = 0; t < 4; ++t) { if (tsel < 0 || tsel == t) {
        const f32x4 qa = *(const LAS f32x4*)(qs + t * 512 + off);
#pragma unroll
        for (int q = 0; q < 8; ++q) c_row_t(B.k[q], B.v[q], delta0 + q * dstep + t, qa, negb, S.a[t], S.l[t]); } }
}
__device__ __forceinline__ void c_desc(int b, int ws, long& idx, long& rstride, int& d0, int& dstep, int& tsel) {
    if (b < 4) { idx = LB - 128 + 32 * ws + 8 * b; rstride = 512; d0 = 128 - 32 * ws - 8 * b; dstep = -1; tsel = -1; }
    else { const int bb = b - 4, t = bb / 6, i = bb % 6, st = (i < 3) ? 4 : 16, j0 = 33 + 24 * ws + 8 * (i % 3); idx = LB + t - st * j0; rstride = -(long)st * 512; d0 = st * j0 - t; dstep = st; tsel = t; }
}
__device__ __forceinline__ void unitD(Frame& F, const Args& A, int n) {
    int tid = (int)threadIdx.x; asm volatile("" : "+v"(tid)); const int lane = tid & 63, w = F.wave;
    const size_t ms0 = (size_t)MP + 4 * n;
    LAS float* RED = (LAS float*)(F.lds + RED_OFF);
    {   const int col = tid, h = col >> 6;
        const float lg = A.in[6][col], lb = A.in[7][col];
        float vnv[4], a[4];
#pragma unroll
        for (int t = 0; t < 4; ++t) { const size_t row = ms0 + t; const float mu = __hip_atomic_load(((float*)F.ws + CW_ST1) + row, RLX_AGENT) * (1.0f / 512.0f), var = __hip_atomic_load(((float*)F.ws + CW_ST2) + row, RLX_AGENT) * (1.0f / 512.0f) - mu * mu, rstd = 1.0f / sqrtf(var + EPS);
            vnv[t] = (bf2f(((bf16*)(F.ws + WS_GV))[row * 512 + col]) - mu) * rstd * lg + lb; F.out[O_VC + (size_t)(4 * n + t) * 512 + col] = vnv[t]; }
#pragma unroll
        for (int i = 0; i < 4; ++i) { float s = A.in[9][h * 128 + i];
#pragma unroll
            for (int j = 0; j <= i; ++j) s += A.in[8][(size_t)(h * 128 + i) * 128 + j] * vnv[j];
            a[i] = bf2f(((bf16*)(F.ws + WS_U))[(ms0 + i) * 512 + col]) * s; const float sq = wave_sum(a[i] * a[i]); if (lane == 0) RED[w * 4 + i] = sq; }
        __syncthreads();
        const float go = A.in[12][col];
#pragma unroll
        for (int i = 0; i < 4; ++i) { float tot = 0.f;
#pragma unroll
            for (int ww = 0; ww < 8; ++ww) tot += RED[ww * 4 + i];
            *(bf16*)((char*)(F.ws + WS_MIX) + pg8::img_off((int)ms0 + i, col, DM / 64)) = (bf16)f2bf(a[i] * (1.0f / sqrtf(tot * (1.0f / 512.0f) + EPS)) * go); }
        __syncthreads();
    }
}
__device__ __forceinline__ void unitC(Frame& F, const Args& A, int n, float negb) {
    int tid = (int)threadIdx.x; asm volatile("" : "+v"(tid)); const int lane = tid & 63, w = F.wave;
    const size_t ms0 = (size_t)MP + 4 * n;
    LAS float* RED = (LAS float*)(F.lds + RED_OFF);
    CState S;
    const float* ck = A.in[2] + (size_t)n * LB * 512; const float* cv = A.in[3] + (size_t)n * LB * 512;
    const int half = w >> 2, ws = w & 3, off = 256 * half + 4 * lane;
    CBuf X, Y;
    { long idx, rs; int d0, ds, ts; c_desc(0, ws, idx, rs, d0, ds, ts); c_issue(X, ck + idx * 512, cv + idx * 512, rs, off); }
    LAS float* qs = (LAS float*)(F.lds + RING_OFF + 73728);
#pragma unroll
    for (int t = 0; t < 4; ++t) { qs[t * 512 + tid] = bf2f(((bf16*)(F.ws + WS_Q))[(ms0 + t) * 512 + tid]); S.a[t] = (f32x4){0.f, 0.f, 0.f, 0.f}; S.l[t] = 0.f; }
    __syncthreads();
#pragma unroll 1
    for (int b = 0; b < 28; b += 2) {
        long idx, rs; int d0, ds, ts, d1, ds1, ts1;
        c_desc(b + 1, ws, idx, rs, d1, ds1, ts1); c_issue(Y, ck + idx * 512, cv + idx * 512, rs, off);
        __builtin_amdgcn_sched_barrier(0);
        c_desc(b, ws, idx, rs, d0, ds, ts); c_consume(X, d0, ds, ts, qs, off, negb, S);
        __builtin_amdgcn_sched_barrier(0);
        if (b + 2 < 28) { c_desc(b + 2, ws, idx, rs, d0, ds, ts); c_issue(X, ck + idx * 512, cv + idx * 512, rs, off); }
        __builtin_amdgcn_sched_barrier(0);
        c_consume(Y, d1, ds1, ts1, qs, off, negb, S);
        __builtin_amdgcn_sched_barrier(0);
    }
    {   const f32x4 k = *(const f32x4*)(F.out + O_KS + (size_t)(4 * n + ws) * 512 + off), v = *(const f32x4*)(F.out + O_VS + (size_t)(4 * n + ws) * 512 + off);
#pragma unroll
        for (int t = 0; t < 4; ++t) { const f32x4 qa = *(const LAS f32x4*)(qs + t * 512 + off); c_row_t(k, v, t - ws, qa, negb, S.a[t], S.l[t]); } }
    LAS float* racc = (LAS float*)(F.lds + RING_OFF); LAS float* rl = (LAS float*)(F.lds + RING_OFF + 65536);
#pragma unroll
    for (int t = 0; t < 4; ++t) { *(LAS f32x4*)(racc + (ws * 4 + t) * 512 + off) = S.a[t]; if ((lane & 15) == 0) rl[(ws * 4 + t) * 8 + 4 * half + (lane >> 4)] = S.l[t]; }
    __syncthreads();
    {   const int col = tid, h = col >> 6; float o[4];
#pragma unroll
        for (int t = 0; t < 4; ++t) { float num = 0.f, den = 0.f;
#pragma unroll
            for (int ww = 0; ww < 4; ++ww) { num += racc[(ww * 4 + t) * 512 + col]; den += rl[(ww * 4 + t) * 8 + h]; }
            o[t] = num / den; const float sq = wave_sum(o[t] * o[t]); if (lane == 0) RED[w * 4 + t] = sq; }
        __syncthreads();
        const float go = A.in[13][col];
#pragma unroll
        for (int t = 0; t < 4; ++t) { float tot = 0.f;
#pragma unroll
            for (int ww = 0; ww < 8; ++ww) tot += RED[ww * 4 + t];
            *(bf16*)((char*)(F.ws + WS_MIX) + pg8::img_off((int)ms0 + t, 512 + col, DM / 64)) = (bf16)f2bf(o[t] * (1.0f / sqrtf(tot * (1.0f / 512.0f) + EPS)) * go); }
        __syncthreads();
    }
}
constexpr int NU_Q = 16 + 64 + 16 + 16;
static_assert(NDEC == 8 * 16 && NBATCH == 8, "queue split");
__device__ __forceinline__ void p2_mixers(Frame& F, const Args& A) {
    const float gqm = wave_max(fabsf(A.in[10][F.lane])), gkm = wave_max(fabsf(A.in[11][F.lane]));
    const float negb = __builtin_bit_cast(float, __builtin_amdgcn_readfirstlane(__builtin_bit_cast(int, -(8.0f * 1.4426950408889634f * 1.02f) * gqm * gkm)));
    const int myq = (int)(xb_xcc_id() & 7u);
#pragma unroll 1
    for (int qq = 0; qq < 8; ++qq) {
        const int q = (myq + qq) & 7;
        for (;;) {
            if (threadIdx.x == 0) F.MISC[0] = __hip_atomic_fetch_add(F.ctl + CW_QUEUE + 64 * q, 1u, RLX_AGENT);
            __syncthreads();
            const int k = (int)F.MISC[0];
            __syncthreads();
            if (k >= NU_Q) break;
            if (k < 16) unitC(F, A, 16 * q + k, negb);
            else if (k < 80) unitA(F, A, 64 * q + (k - 16), negb);
            else if (k < 96) unitB(F, A, 16 * q + (k - 80));
            else unitD(F, A, 16 * q + (k - 96));
        }
    }
}

template <int K, int MODE>
__device__ __forceinline__ void skinny_tile(Frame& F, const Args& A, const bf16* Am  , const bf16* Bt  ) {
    int lane = (int)threadIdx.x & 63; asm volatile("" : "+v"(lane));
    const int w = F.wave, il = lane & 31, hi = lane >> 5;
    for (int tile = (int)blockIdx.x; tile < 256; tile += (int)gridDim.x) {
    const int r0 = 64 * (tile >> 5), c0 = 32 * (tile & 31);
    constexpr int KW = K / 8, NK = KW / 16;
    const char* ab = (const char*)Am; const char* bb = (const char*)Bt; const int arow = MP + r0 + il, brow = c0 + il, kc0 = w * KW + 8 * hi;
    f32x16 acc0, acc1;
#pragma unroll
    for (int q = 0; q < 16; ++q) { acc0[q] = 0.f; acc1[q] = 0.f; }
    constexpr int CH = (NK % 8 == 0) ? 8 : 11;
    static_assert(NK % CH == 0, "skinny_tile: K slice");
#pragma unroll 1
    for (int k0 = 0; k0 < NK; k0 += CH) {
        bf16x8 bf[CH], a0[CH], a1[CH];
#pragma unroll
        for (int c = 0; c < CH; ++c) { const int kc = kc0 + 16 * (k0 + c); bf[c] = *(const bf16x8*)(bb + pg8::img_off_b(brow, kc, K / 64)); a0[c] = *(const bf16x8*)(ab + pg8::img_off(arow, kc, K / 64)); a1[c] = *(const bf16x8*)(ab + pg8::img_off(arow + 32, kc, K / 64)); }
#pragma unroll
        for (int c = 0; c < CH; ++c) { acc0 = __builtin_amdgcn_mfma_f32_32x32x16_bf16(bf[c], a0[c], acc0, 0, 0, 0); acc1 = __builtin_amdgcn_mfma_f32_32x32x16_bf16(bf[c], a1[c], acc1, 0, 0, 0); }
    }
    LAS float* red = (LAS float*)(F.lds + RING_OFF);
#pragma unroll
    for (int q = 0; q < 16; ++q) { red[((w * 2 + 0) * 16 + q) * 64 + lane] = acc0[q]; red[((w * 2 + 1) * 16 + q) * 64 + lane] = acc1[q]; }
    __syncthreads();
    const int rb = w >> 2, qg = w & 3;
    f32x4 v = (f32x4){0.f, 0.f, 0.f, 0.f};
#pragma unroll
    for (int ww = 0; ww < 8; ++ww)
#pragma unroll
        for (int j = 0; j < 4; ++j) v[j] += red[((ww * 2 + rb) * 16 + 4 * qg + j) * 64 + lane];
    const int srow = r0 + 32 * rb + il, col = c0 + 8 * qg + 4 * hi;
    float* yp = F.out + O_Y + (size_t)(MP + srow) * DM + col;
    if (MODE == 0) {
        const f32x4 x = *(const f32x4*)(A.in[1] + (size_t)srow * DM + col); v = v + x;
        v2u o; o.x = pk2(v[0], v[1]); o.y = pk2(v[2], v[3]); *(v2u*)((char*)(F.ws + WS_X1B) + pg8::img_off(MP + srow, col, DM / 64)) = o;
        float s = (v[0] * v[0] + v[1] * v[1]) + (v[2] * v[2] + v[3] * v[3]); s += __shfl_xor(s, 32);
        if (hi == 0) atomicAdd((float*)F.ws + CW_SS + MP + srow, s);
    } else {
        const v2u xb = *(const v2u*)((const char*)(F.ws + WS_X1B) + pg8::img_off(MP + srow, col, DM / 64)); *(f32x4*)yp = v + (f32x4){bf_lo(xb.x), bf_hi(xb.x), bf_lo(xb.y), bf_hi(xb.y)};
    }
    __syncthreads();
    }
}
__global__ void __launch_bounds__(NWAVES * 64, 2) hymba_fwd(Args args) {
    extern __shared__ __attribute__((aligned(16))) unsigned char lds[];
    Frame F;
    F.lds = (LAS unsigned char*)lds;
    F.MISC = (volatile LAS unsigned*)(F.lds + MISC_OFF);
    F.tid = threadIdx.x; F.lane = F.tid & 63; F.wave = __builtin_amdgcn_readfirstlane(F.tid >> 6);
    F.G = gridDim.x; { const int bx = blockIdx.x; F.vcu = (F.G % 8 == 0) ? (bx % 8) * (F.G / 8) + bx / 8 : bx; }
    unsigned char* ws = args.ws;
    F.ctl = (gu32*)(ws + WS_CTL); F.ws = ws; F.out = args.out;
    for (int u = F.tid; u < (LDS_BYTES - LDSCTL_OFF) / 4; u += NWAVES * 64) ((LAS unsigned*)(F.lds + LDSCTL_OFF))[u] = 0u;
    __syncthreads();
    XcdBarrier bar; bar.bar = (unsigned*)(F.ctl + CW_BAR); bar.x = 0; bar.st = nullptr;
    if (N_LAUNCHES != PER_PHASE) bar = xcd_barrier_post((unsigned*)(F.ctl + CW_BAR), F.MISC + 8);
#define GRID_BAR(seam) do { if (N_LAUNCHES == PER_PHASE) { if (F.tid == 0) __hip_atomic_store(F.ctl + CW_TMO, 0xBADBA0u | (unsigned)(seam), RLX_AGENT); } else { xcd_barrier(bar); } } while (0)
    const int lo = args.ph_lo, hi = args.ph_hi;
#define IN(k) (lo <= (k) && (k) < hi)
#define BOTH(k) (IN(k) && IN((k) + 1))
    if (IN(0)) { p0_prologue(F, args); if (BOTH(0)) GRID_BAR(0); }
    if (IN(1)) {
        pg8::Gemm g{(const bf16*)(ws + WS_XN), (const bf16*)(ws + WS_WIN), M, NIN, DM}; pg8::StaticOrder S; S.init(M, NIN, F.G, (int)blockIdx.x);
        pg8::EpiIn E{ws, args.out, args.in[10], args.in[11]};
        pg8::gemm_phase<pg8::EpiIn, pg8::StaticOrder, PG8_ALIGN, PG8_SP2>(F.lds + RING_OFF, g, S, E);
        if (BOTH(1)) GRID_BAR(1);
    }
    if (IN(2)) { p2_mixers(F, args); if (BOTH(2)) GRID_BAR(2); }
    if (IN(3)) {
        pg8::Gemm g{(const bf16*)(ws + WS_MIX), (const bf16*)(ws + WS_WO), MP, DM, DM}; pg8::StaticOrder S; S.init(MP, DM, F.G, (int)blockIdx.x);
        pg8::EpiWo E{args.in[0], args.in[1], args.out, ws};
        pg8::gemm_phase<pg8::EpiWo, pg8::StaticOrder, PG8_ALIGN, PG8_SP2>(F.lds + RING_OFF, g, S, E);
        skinny_tile<DM, 0>(F, args, (const bf16*)(ws + WS_MIX), (const bf16*)(ws + WS_WO));
        if (BOTH(3)) GRID_BAR(3);
    }
    if (IN(4)) {
        pg8::Gemm g{(const bf16*)(ws + WS_X1B), (const bf16*)(ws + WS_WGU), M, NGU, DM}; pg8::StaticOrder S; S.init(M, NGU, F.G, (int)blockIdx.x);
        pg8::EpiGU E{ws};
        pg8::gemm_phase<pg8::EpiGU, pg8::StaticOrder, PG8_ALIGN, PG8_SP2>(F.lds + RING_OFF, g, S, E);
        if (BOTH(4)) GRID_BAR(4);
    }
    if (IN(5)) {
        pg8::Gemm g{(const bf16*)(ws + WS_H), (const bf16*)(ws + WS_WD), MP, DM, DFF}; pg8::StaticOrder S; S.init(MP, DM, F.G, (int)blockIdx.x);
        pg8::EpiDown E{args.out, ws};
        pg8::gemm_phase<pg8::EpiDown, pg8::StaticOrder, PG8_ALIGN, PG8_SP2>(F.lds + RING_OFF, g, S, E);
        skinny_tile<DFF, 1>(F, args, (const bf16*)(ws + WS_H), (const bf16*)(ws + WS_WD));
    }
#undef IN
#undef BOTH
}

extern "C" void kernel_launch(void* const* d_in, const int* in_sizes, int n_in, void* d_out, int out_size, void* d_ws, size_t ws_size, hipStream_t stream) {
    static int grid = 0;
    if (grid == 0) {
        if (n_in != 19 || in_sizes[0] != MP * DM || in_sizes[1] != MS * DM || (size_t)out_size != O_END || ws_size < WS_END) { fprintf(stderr, "kernel_launch: unexpected shapes (n_in %d, in0 %d, out %d, ws %zu); nothing launched\n", n_in, n_in > 0 ? in_sizes[0] : -1, out_size, ws_size); grid = -1; return; }
        int dev = 0, cus = 0, per_cu = 0;
        if (hipGetDevice(&dev) != hipSuccess || hipDeviceGetAttribute(&cus, hipDeviceAttributeMultiprocessorCount, dev) != hipSuccess) { grid = -1; return; }
        if (hipFuncSetAttribute((const void*)hymba_fwd, hipFuncAttributeMaxDynamicSharedMemorySize, LDS_BYTES) != hipSuccess) { fprintf(stderr, "kernel_launch: hipFuncSetAttribute failed\n"); grid = -1; return; }
        if (hipOccupancyMaxActiveBlocksPerMultiprocessor(&per_cu, (const void*)hymba_fwd, NWAVES * 64, LDS_BYTES) != hipSuccess || per_cu < 1) fprintf(stderr, "kernel_launch: occupancy query reports %d\n", per_cu);
        (void)hipGetLastError();
        grid = cus;
    }
    if (grid < 0) return;
    if (hipMemsetAsync((char*)d_ws + WS_CTL, 0, CTL_ZERO_BYTES, stream) != hipSuccess) { fprintf(stderr, "kernel_launch: hipMemsetAsync failed\n"); return; }
    Args a{};
    for (int i = 0; i < 19; ++i) a.in[i] = (const float*)d_in[i];
    a.out = (float*)d_out; a.ws = (unsigned char*)d_ws;
    for (int li = 0; li < N_LAUNCHES; ++li) {
        a.ph_lo = (N_LAUNCHES == PER_PHASE) ? li : 0; a.ph_hi = (N_LAUNCHES == PER_PHASE) ? li + 1 : PER_PHASE;
        hipLaunchKernelGGL(hymba_fwd, dim3(grid), dim3(NWAVES * 64), LDS_BYTES, stream, a);
        const hipError_t le = hipPeekAtLastError();
        if (le != hipSuccess) { fprintf(stderr, "kernel_launch: launch %d failed: %s\n", li, hipGetErrorName(le)); break; }
    }
}
```

```cpp
#include <hip/hip_runtime.h>
#include <cstdio>
#include <cstdint>
namespace pg8 {
#define PG8_LAS __attribute__((address_space(3)))
typedef unsigned short bf16_t;
typedef short bf16x8 __attribute__((ext_vector_type(8)));
typedef float f32x4 __attribute__((ext_vector_type(4)));
typedef unsigned u32x4 __attribute__((ext_vector_type(4)));
constexpr int BM = 256, BK = 64, HALF = 128, HTB = HALF * BK * 2  , STAGE_BYTES = 8 * HTB, NXCD = 8, WGM = 8;

__host__ __device__ __forceinline__ int lds_byte(int r, int c) { const int st = (r >> 4) * 2 + (c >> 5), rr = r & 15, cc = c & 31, ob = rr * 64 + cc * 2; return st * 1024 + (ob ^ (((ob >> 9) & 1) << 5)); }
__host__ __device__ __forceinline__ void stage_rc(int b, int& R, int& C) { const int st = b / 1024, sb = b % 1024, swz = sb ^ (((sb >> 9) & 1) << 5); R = (st >> 1) * 16 + swz / 64; C = (st & 1) * 32 + (swz % 64) / 2; }
__host__ __device__ __forceinline__ int perm32(int rho) { const int n = rho >> 4, i = rho & 15; return 8 * (i >> 2) + 4 * n + (i & 3); }

__host__ __device__ __forceinline__ int invperm32(int x) { return 16 * ((x >> 2) & 1) + 4 * (x >> 3) + (x & 3); }
__host__ __device__ __forceinline__ size_t img_off(int row, int col, int nkt) { return ((size_t)((row >> 7) * nkt + (col >> 6)) << 14) + (size_t)lds_byte(row & 127, col & 63); }
__host__ __device__ __forceinline__ size_t img_off_b(int row, int col, int nkt) { return img_off((row & ~31) | invperm32(row & 31), col, nkt); }
struct Unit { int pm, pn; };
struct Gemm { const bf16_t* A; const bf16_t* Bt; int M, N, K; };

struct StaticOrder {
    int nM, nN, nwg, G, c;
    __host__ __device__ void init(int M, int N, int G_, int c_) { nM = M / BM; nN = N / BM; nwg = nM * nN; G = G_; c = c_; }
    __host__ __device__ bool next(int i, Unit& u) const {
        const long L = (long)i * G + c; if (L >= nwg) return false;
        int wgid = (int)L; { const int q = nwg / NXCD, r = nwg % NXCD, xcd = wgid % NXCD, off = wgid / NXCD; wgid = (xcd < r ? xcd * (q + 1) : r * (q + 1) + (xcd - r) * q) + off; }
        const int nig = WGM * nN, gid = wgid / nig, fm = gid * WGM, gsz = (nM - fm) < WGM ? (nM - fm) : WGM;
        u.pm = fm + ((wgid % nig) % gsz); u.pn = (wgid % nig) / gsz; return true;
    }
    __device__ __forceinline__ void a_ready(const Unit&) const {}
    __device__ __forceinline__ void done(const Unit&) const {}
};

__device__ __forceinline__ unsigned cvt_pk_bf16(float lo, float hi) { unsigned r; asm volatile("v_cvt_pk_bf16_f32 %0, %1, %2" : "=v"(r) : "v"(lo), "v"(hi)); return r; }
typedef float f32x2 __attribute__((ext_vector_type(2)));
__device__ __forceinline__ float fast_exp2(float x) { return __builtin_amdgcn_exp2f(x); }
__device__ __forceinline__ float fast_rcp(float x) { return __builtin_amdgcn_rcpf(x); }
__device__ __forceinline__ float gelu_t(float x) { const float u = 0.7978845608028654f * (x + 0.044715f * x * x * x); return x * fast_rcp(1.0f + fast_exp2(-2.8853900817779268f * u)); }
__device__ __forceinline__ float silu_f(float x) { return x * fast_rcp(1.0f + fast_exp2(-1.4426950408889634f * x)); }
__device__ __forceinline__ float quad_sum(float s) { s += __shfl_xor(s, 16); s += __shfl_xor(s, 32); return s; }

constexpr size_t EW_U = 66u << 20, EW_GV = 83u << 20, EW_Q = 100u << 20, EW_K = 117u << 20, EW_V = 134u << 20, EW_X1B = 186u << 20, EW_H = 220u << 20;
constexpr int EC_ST1 = 16384, EC_ST2 = EC_ST1 + 16896, EC_SS = EC_ST2 + 16896;
constexpr size_t EO_KP = (size_t)16896 * 1024, EO_VP = EO_KP + (size_t)16384 * 512, EO_KS = EO_VP + (size_t)16384 * 512, EO_VS = EO_KS + (size_t)512 * 512;
constexpr int XM_PROMPT = 16384;
constexpr float QSCALE = 0.125f * 1.4426950408889634f;

struct EpiIn {
    static constexpr bool PERM = true, AFTER_DRAIN = false;
    unsigned char* ws; float* out; const float *gq, *gk;
    __device__ __forceinline__ void operator()(const f32x4 (&acc)[2][2][4][2], const Unit& u, int wr, int wc, int fr, int fq) const {
        const int row0 = u.pm * BM + wr * 64 + fr; const int pn = u.pn;
        if (pn < 4) {
            bf16_t* dst = (bf16_t*)(ws + ((pn < 2) ? EW_U : EW_GV)); float* st1 = (float*)ws + EC_ST1; float* st2 = (float*)ws + EC_ST2; const int col0 = (pn & 1) * 256 + wc * 32 + 8 * fq; const bool stats = pn >= 2;
#pragma unroll
            for (int ai = 0; ai < 2; ++ai)
#pragma unroll
                for (int m = 0; m < 4; ++m) { const int row = row0 + ai * HALF + m * 16; bf16_t* rowp = dst + (size_t)row * 512 + col0; float s1 = 0.f, s2 = 0.f;
#pragma unroll
                    for (int bj = 0; bj < 2; ++bj) { f32x4 v0 = acc[ai][bj][m][0], v1 = acc[ai][bj][m][1];
#pragma unroll
                        for (int j = 0; j < 4; ++j) { v0[j] = gelu_t(v0[j]); v1[j] = gelu_t(v1[j]); }
                        s1 += (v0[0] + v0[1]) + (v0[2] + v0[3]) + (v1[0] + v1[1]) + (v1[2] + v1[3]);
                        s2 += (v0[0] * v0[0] + v0[1] * v0[1]) + (v0[2] * v0[2] + v0[3] * v0[3]) + (v1[0] * v1[0] + v1[1] * v1[1]) + (v1[2] * v1[2] + v1[3] * v1[3]);
                        u32x4 w; w.x = cvt_pk_bf16(v0[0], v0[1]); w.y = cvt_pk_bf16(v0[2], v0[3]); w.z = cvt_pk_bf16(v1[0], v1[1]); w.w = cvt_pk_bf16(v1[2], v1[3]);
                        *(u32x4*)(rowp + bj * HALF) = w; }
                    if (stats) { s1 = quad_sum(s1); s2 = quad_sum(s2); if (fq == 0) { atomicAdd(st1 + row, s1); atomicAdd(st2 + row, s2); } } }
        } else {
            const int sec = pn >> 1, head = 4 * (pn & 1) + wc; const bool prompt = u.pm < (XM_PROMPT / BM);
            bf16_t* dst = (bf16_t*)(ws + ((sec == 2) ? EW_Q : (sec == 3) ? EW_K : EW_V)); const float* gp = (sec == 2) ? gq : gk;
            float* fo = (sec == 2) ? nullptr : out + ((sec == 3) ? (prompt ? EO_KP : EO_KS) : (prompt ? EO_VP : EO_VS));
            f32x4 gv[2][2];
#pragma unroll
            for (int bj = 0; bj < 2; ++bj)
#pragma unroll
                for (int n = 0; n < 2; ++n) gv[bj][n] = (sec < 4) ? *(const f32x4*)(gp + 32 * bj + 8 * fq + 4 * n) : (f32x4){1.f, 1.f, 1.f, 1.f};
            const float post = (sec == 2) ? QSCALE : 1.0f;
#pragma unroll
            for (int ai = 0; ai < 2; ++ai)
#pragma unroll
                for (int m = 0; m < 4; ++m) { const int row = row0 + ai * HALF + m * 16; const int orow = prompt ? row : row - XM_PROMPT;
                    float ss = 0.f;
#pragma unroll
                    for (int bj = 0; bj < 2; ++bj)
#pragma unroll
                        for (int n = 0; n < 2; ++n) { const f32x4 x = acc[ai][bj][m][n]; ss += (x[0] * x[0] + x[1] * x[1]) + (x[2] * x[2] + x[3] * x[3]); }
                    ss = quad_sum(ss);
                    const float rr = (sec < 4) ? post * (1.0f / sqrtf(ss * (1.0f / 64.0f) + 1e-6f)) : 1.0f;
#pragma unroll
                    for (int bj = 0; bj < 2; ++bj) { const f32x4 v0 = acc[ai][bj][m][0] * rr * gv[bj][0], v1 = acc[ai][bj][m][1] * rr * gv[bj][1];
                        const int dcol = 64 * head + 32 * bj + 8 * fq;
                        u32x4 w; w.x = cvt_pk_bf16(v0[0], v0[1]); w.y = cvt_pk_bf16(v0[2], v0[3]); w.z = cvt_pk_bf16(v1[0], v1[1]); w.w = cvt_pk_bf16(v1[2], v1[3]);
                        *(u32x4*)(dst + (size_t)row * 512 + dcol) = w;
                        if (fo) { float* op = fo + (size_t)orow * 512 + dcol; if (prompt) { __builtin_nontemporal_store(v0, (f32x4*)op); __builtin_nontemporal_store(v1, (f32x4*)(op + 4)); } else { *(f32x4*)op = v0; *(f32x4*)(op + 4) = v1; } } } }
        }
    }
};
struct EpiWo {
    static constexpr bool PERM = true, AFTER_DRAIN = false;
    const float *xp, *xs; float* y; unsigned char* ws;
    __device__ __forceinline__ void operator()(const f32x4 (&acc)[2][2][4][2], const Unit& u, int wr, int wc, int fr, int fq) const {
        const int row0 = u.pm * BM + wr * 64 + fr; const int col0 = u.pn * BM + wc * 32 + 8 * fq;
        const float* xb = (u.pm < XM_PROMPT / BM) ? xp : (xs - (size_t)XM_PROMPT * 1024); bf16_t* x1b = (bf16_t*)(ws + EW_X1B); float* ss = (float*)ws + EC_SS;
#pragma unroll
        for (int ai = 0; ai < 2; ++ai)
#pragma unroll
            for (int m = 0; m < 4; ++m) { const int row = row0 + ai * HALF + m * 16; const size_t off = (size_t)row * 1024 + col0; float s = 0.f;
#pragma unroll
                for (int bj = 0; bj < 2; ++bj) { const f32x4 x0 = *(const f32x4*)(xb + off + bj * HALF), x1 = *(const f32x4*)(xb + off + bj * HALF + 4);
                    const f32x4 v0 = acc[ai][bj][m][0] + x0, v1 = acc[ai][bj][m][1] + x1;
                    s += (v0[0] * v0[0] + v0[1] * v0[1]) + (v0[2] * v0[2] + v0[3] * v0[3]) + (v1[0] * v1[0] + v1[1] * v1[1]) + (v1[2] * v1[2] + v1[3] * v1[3]);
                    u32x4 w; w.x = cvt_pk_bf16(v0[0], v0[1]); w.y = cvt_pk_bf16(v0[2], v0[3]); w.z = cvt_pk_bf16(v1[0], v1[1]); w.w = cvt_pk_bf16(v1[2], v1[3]);
                    *(u32x4*)((char*)x1b + img_off(row, col0 + bj * HALF, 16)) = w; }
                s = quad_sum(s); if (fq == 0) atomicAdd(ss + row, s); }
    }
};
struct EpiGU {
    static constexpr bool PERM = true, AFTER_DRAIN = false;
    unsigned char* ws;
    __device__ __forceinline__ void operator()(const f32x4 (&acc)[2][2][4][2], const Unit& u, int wr, int wc, int fr, int fq) const {
        const int row0 = u.pm * BM + wr * 64 + fr; const int col0 = u.pn * HALF + wc * 32 + 8 * fq; const float* ss = (const float*)ws + EC_SS; bf16_t* H = (bf16_t*)(ws + EW_H);
#pragma unroll
        for (int ai = 0; ai < 2; ++ai)
#pragma unroll
            for (int m = 0; m < 4; ++m) { const int row = row0 + ai * HALF + m * 16;
                const float r = 1.0f / sqrtf(__hip_atomic_load(ss + row, __ATOMIC_RELAXED, __HIP_MEMORY_SCOPE_AGENT) * (1.0f / 1024.0f) + 1e-6f);
                float a[8];
#pragma unroll
                for (int n = 0; n < 2; ++n)
#pragma unroll
                    for (int j = 0; j < 4; ++j) a[4 * n + j] = silu_f(acc[ai][0][m][n][j] * r) * (acc[ai][1][m][n][j] * r);
                u32x4 w; w.x = cvt_pk_bf16(a[0], a[1]); w.y = cvt_pk_bf16(a[2], a[3]); w.z = cvt_pk_bf16(a[4], a[5]); w.w = cvt_pk_bf16(a[6], a[7]);
                *(u32x4*)((char*)H + img_off(row, col0, 44)) = w; }
    }
};
struct EpiDown {
    static constexpr bool PERM = true, AFTER_DRAIN = false;
    float* y; const unsigned char* ws;
    __device__ __forceinline__ void operator()(const f32x4 (&acc)[2][2][4][2], const Unit& u, int wr, int wc, int fr, int fq) const {
        const int row0 = u.pm * BM + wr * 64 + fr; const int col0 = u.pn * BM + wc * 32 + 8 * fq; const char* x1b = (const char*)(ws + EW_X1B);
#pragma unroll
        for (int ai = 0; ai < 2; ++ai)
#pragma unroll
            for (int m = 0; m < 4; ++m) { const int row = row0 + ai * HALF + m * 16; const size_t off = (size_t)row * 1024 + col0;
#pragma unroll
                for (int bj = 0; bj < 2; ++bj) { const u32x4 xb = *(const u32x4*)(x1b + img_off(row, col0 + bj * HALF, 16)); float* p = y + off + bj * HALF;
                    const f32x4 x0 = (f32x4){__builtin_bit_cast(float, xb.x << 16), __builtin_bit_cast(float, xb.x & 0xffff0000u), __builtin_bit_cast(float, xb.y << 16), __builtin_bit_cast(float, xb.y & 0xffff0000u)};
                    const f32x4 x1 = (f32x4){__builtin_bit_cast(float, xb.z << 16), __builtin_bit_cast(float, xb.z & 0xffff0000u), __builtin_bit_cast(float, xb.w << 16), __builtin_bit_cast(float, xb.w & 0xffff0000u)};
                    __builtin_nontemporal_store(acc[ai][bj][m][0] + x0, (f32x4*)p); __builtin_nontemporal_store(acc[ai][bj][m][1] + x1, (f32x4*)(p + 4)); } }
    }
};

template <class Epi, class Sched, bool ALIGN_EPI = false, bool SP2 = false>
__device__ __forceinline__ void gemm_phase(PG8_LAS unsigned char* lds, const Gemm g, const Sched& S, const Epi& E) {
    const int tid = threadIdx.x, wid = __builtin_amdgcn_readfirstlane(tid >> 6), lane = tid & 63, wr = wid >> 2, wc = wid & 3, fr = lane & 15, fq = lane >> 4;
    const int K = g.K, nt = K / BK;
    unsigned voffA[2], voffB[2];
#pragma unroll
    for (int i = 0; i < 2; ++i) { voffA[i] = (unsigned)(tid * 16 + i * 8192); voffB[i] = voffA[i]; }
    static_assert(Epi::PERM, "image layout: B images are written with the perm32 row order");
    const size_t kstep = (size_t)HTB;
    const size_t hstep = (size_t)HALF * K * 2;
    const size_t tstep = 2 * hstep;
    const unsigned ldsw = (unsigned)wid * 1024u;
    const int aoff = lds_byte(wr * 64 + fr, fq * 8), boff = lds_byte(wc * 32 + fr, fq * 8);
#define PG8_SA(b, h) (((b) * 2 + (h)) * HTB)
#define PG8_SB(b, h) ((4 + (b) * 2 + (h)) * HTB)
#define PG8_STAGE(bufoff, gbase, voff) do { _Pragma("unroll") for (int _i = 0; _i < 2; ++_i) \
        __builtin_amdgcn_global_load_lds((const unsigned*)((const char*)(gbase) + (voff)[_i]), (PG8_LAS unsigned*)(lds + (bufoff) + ldsw + _i * 8192), 16, 0, 0); } while (0)
#define PG8_LDA(dst, b, h) do { _Pragma("unroll") for (int m = 0; m < 4; ++m) _Pragma("unroll") for (int k = 0; k < 2; ++k) dst[m][k] = *(const PG8_LAS bf16x8*)(lds + PG8_SA(b, h) + aoff + m * 2048 + k * 1024); } while (0)
#define PG8_LDB(dst, b, h) do { _Pragma("unroll") for (int n = 0; n < 2; ++n) _Pragma("unroll") for (int k = 0; k < 2; ++k) dst[n][k] = *(const PG8_LAS bf16x8*)(lds + PG8_SB(b, h) + boff + n * 2048 + k * 1024); } while (0)
#define PG8_MMA(ai, bj, At, Bt) do { __builtin_amdgcn_s_setprio(1); _Pragma("unroll") for (int m = 0; m < 4; ++m) _Pragma("unroll") for (int n = 0; n < 2; ++n) _Pragma("unroll") for (int k = 0; k < 2; ++k) \
        acc[ai][bj][m][n] = __builtin_amdgcn_mfma_f32_16x16x32_bf16(Bt[n][k], At[m][k], acc[ai][bj][m][n], 0, 0, 0); __builtin_amdgcn_s_setprio(0); } while (0)
#define PG8_WAIT_V(n) asm volatile("s_waitcnt vmcnt(" #n ")" ::: "memory")
#define PG8_WAIT_L(n) asm volatile("s_waitcnt lgkmcnt(" #n ")" ::: "memory")
#define PG8_BAR __builtin_amdgcn_s_barrier()
#define PG8_SCHED __builtin_amdgcn_sched_barrier(0)
    Unit cur, nxt; int ui = 0;
    if (!S.next(0, cur)) return;
    f32x4 acc[2][2][4][2];
#pragma unroll
    for (int a = 0; a < 2; ++a)
#pragma unroll
        for (int b = 0; b < 2; ++b)
#pragma unroll
            for (int m = 0; m < 4; ++m)
#pragma unroll
                for (int n = 0; n < 2; ++n) acc[a][b][m][n] = (f32x4){0.f, 0.f, 0.f, 0.f};
    bf16x8 At[4][2], B0[2][2], B1[2][2];
    const char* cA = (const char*)g.A + (size_t)cur.pm * tstep; const char* cB = (const char*)g.Bt + (size_t)cur.pn * tstep;
    S.a_ready(cur);
    if constexpr (SP2) {
        PG8_STAGE(PG8_SB(0, 0), cB, voffB); PG8_STAGE(PG8_SB(0, 1), cB + hstep, voffB); PG8_STAGE(PG8_SA(0, 0), cA, voffA); PG8_STAGE(PG8_SA(0, 1), cA + hstep, voffA);
        if (wr == 1) PG8_BAR;
        PG8_WAIT_V(2); PG8_BAR;
        PG8_STAGE(PG8_SB(1, 0), cB + kstep, voffB); PG8_STAGE(PG8_SA(1, 0), cA + kstep, voffA); PG8_STAGE(PG8_SB(1, 1), cB + hstep + kstep, voffB);
        PG8_WAIT_V(6); PG8_BAR;
    } else {
        PG8_STAGE(PG8_SB(0, 0), cB, voffB); PG8_STAGE(PG8_SA(0, 0), cA, voffA); PG8_STAGE(PG8_SB(0, 1), cB + hstep, voffB); PG8_STAGE(PG8_SA(0, 1), cA + hstep, voffA);
        if (wr == 1) PG8_BAR;
        PG8_WAIT_V(4); PG8_BAR;
        PG8_STAGE(PG8_SB(1, 0), cB + kstep, voffB); PG8_STAGE(PG8_SA(1, 0), cA + kstep, voffA); PG8_STAGE(PG8_SB(1, 1), cB + hstep + kstep, voffB);
        PG8_WAIT_V(6); PG8_BAR;
    }
    for (;;) {
        const bool has_next = S.next(ui + 1, nxt);
        const char* nA = has_next ? (const char*)g.A + (size_t)nxt.pm * tstep : cA; const char* nB = has_next ? (const char*)g.Bt + (size_t)nxt.pn * tstep : cB;
        for (int t = 0; t < nt; t += 2) {
            const bool last = (t == nt - 2);
            const char* a1 = cA + (size_t)(t + 1) * kstep;
            const char* a2 = last ? nA : cA + (size_t)(t + 2) * kstep; const char* b2 = last ? nB : cB + (size_t)(t + 2) * kstep;
            const char* a3 = a2 + kstep; const char* b3 = b2 + kstep;
            if (last && has_next) S.a_ready(nxt);
            if constexpr (SP2) {
            PG8_LDB(B0, 0, 0); PG8_LDB(B1, 0, 1); PG8_SCHED; PG8_LDA(At, 0, 0); PG8_STAGE(PG8_SA(1, 1), a1 + hstep, voffA);
            PG8_WAIT_V(8); PG8_WAIT_L(0); PG8_BAR; PG8_MMA(0, 0, At, B0); PG8_MMA(0, 1, At, B1); PG8_BAR; PG8_SCHED;
            PG8_LDA(At, 0, 1); PG8_STAGE(PG8_SB(0, 0), b2, voffB); PG8_STAGE(PG8_SB(0, 1), b2 + hstep, voffB); PG8_STAGE(PG8_SA(0, 0), a2, voffA);
            PG8_WAIT_V(8); PG8_WAIT_L(0); PG8_BAR; PG8_MMA(1, 0, At, B0); PG8_MMA(1, 1, At, B1); PG8_BAR; PG8_SCHED;
            PG8_LDB(B0, 1, 0); PG8_LDB(B1, 1, 1); PG8_SCHED; PG8_LDA(At, 1, 0); PG8_STAGE(PG8_SA(0, 1), a2 + hstep, voffA);
            PG8_WAIT_V(8); PG8_WAIT_L(0); PG8_BAR; PG8_MMA(0, 0, At, B0); PG8_MMA(0, 1, At, B1); PG8_BAR; PG8_SCHED;
            PG8_LDA(At, 1, 1); PG8_STAGE(PG8_SB(1, 0), b3, voffB); PG8_STAGE(PG8_SB(1, 1), b3 + hstep, voffB); PG8_STAGE(PG8_SA(1, 0), a3, voffA);
            PG8_WAIT_V(8); PG8_WAIT_L(0); PG8_BAR; PG8_MMA(1, 0, At, B0); PG8_MMA(1, 1, At, B1); PG8_BAR; PG8_SCHED;
            } else {
            PG8_LDB(B0, 0, 0); PG8_SCHED; PG8_LDA(At, 0, 0); PG8_STAGE(PG8_SA(1, 1), a1 + hstep, voffA);
            PG8_WAIT_L(8); PG8_BAR; PG8_WAIT_L(0); PG8_MMA(0, 0, At, B0); PG8_BAR; PG8_SCHED;
            PG8_LDB(B1, 0, 1); PG8_STAGE(PG8_SB(0, 0), b2, voffB);
            PG8_BAR; PG8_WAIT_L(0); PG8_MMA(0, 1, At, B1); PG8_BAR;
            PG8_LDA(At, 0, 1); PG8_STAGE(PG8_SA(0, 0), a2, voffA);
            PG8_BAR; PG8_WAIT_L(0); PG8_MMA(1, 0, At, B0); PG8_BAR; PG8_SCHED;
            PG8_STAGE(PG8_SB(0, 1), b2 + hstep, voffB);
            PG8_WAIT_V(6); PG8_BAR; PG8_MMA(1, 1, At, B1); PG8_BAR;
            PG8_LDB(B0, 1, 0); PG8_SCHED; PG8_LDA(At, 1, 0); PG8_STAGE(PG8_SA(0, 1), a2 + hstep, voffA);
            PG8_WAIT_L(8); PG8_BAR; PG8_WAIT_L(0); PG8_MMA(0, 0, At, B0); PG8_BAR; PG8_SCHED;
            PG8_LDB(B1, 1, 1); PG8_STAGE(PG8_SB(1, 0), b3, voffB);
            PG8_BAR; PG8_WAIT_L(0); PG8_MMA(0, 1, At, B1); PG8_BAR;
            PG8_LDA(At, 1, 1); PG8_STAGE(PG8_SA(1, 0), a3, voffA);
            PG8_BAR; PG8_WAIT_L(0); PG8_MMA(1, 0, At, B0); PG8_BAR; PG8_SCHED;
            PG8_STAGE(PG8_SB(1, 1), b3 + hstep, voffB);
            PG8_WAIT_V(6); PG8_BAR; PG8_MMA(1, 1, At, B1); PG8_BAR;
            }
        }
        if constexpr (ALIGN_EPI) { if (wr == 0) PG8_BAR; }
        if constexpr (!Epi::AFTER_DRAIN) { E(acc, cur, wr, wc, fr, fq); S.done(cur); }
        if (!has_next) break;
#pragma unroll
        for (int a = 0; a < 2; ++a)
#pragma unroll
            for (int b = 0; b < 2; ++b)
#pragma unroll
                for (int m = 0; m < 4; ++m)
#pragma unroll
                    for (int n = 0; n < 2; ++n) acc[a][b][m][n] = (f32x4){0.f, 0.f, 0.f, 0.f};
        cur = nxt; cA = nA; cB = nB; ++ui;
        if constexpr (ALIGN_EPI) { if (wr == 1) PG8_BAR; }
    }
    PG8_WAIT_V(0);
    if constexpr (!ALIGN_EPI) { if (wr == 0) PG8_BAR; }
    PG8_BAR;
    if constexpr (Epi::AFTER_DRAIN) { E.fused(acc, cur, wr, wc, fr, fq, lds, wid, lane); S.done(cur); }
#undef PG8_SA
#undef PG8_SB
#undef PG8_STAGE
#undef PG8_LDA
#undef PG8_LDB
#undef PG8_MMA
#undef PG8_WAIT_V
#undef PG8_WAIT_L
#undef PG8_BAR
#undef PG8_SCHED
}
}
#ifndef PG8_SP2
#define PG8_SP2 true
#endif
#ifndef PG8_ALIGN
#define PG8_ALIGN true
#endif
#ifndef MK_N_LAUNCHES
#define MK_N_LAUNCHES 1
#endif
constexpr int NWAVES = 8;
constexpr int N_LAUNCHES = MK_N_LAUNCHES;
constexpr int PER_PHASE = 6;

constexpr int DM = 1024, SEQ = 2048, NBATCH = 8, MP = NBATCH * SEQ, NDEC = 128, TDEC = 4, MS = NDEC * TDEC, M = MP + MS;
constexpr int WA = 512, NIN = 2560, DFF = 2816, NGU = 2 * DFF, LB = 2048;
constexpr float EPS = 1e-6f;
constexpr size_t O_Y = 0, O_KP = (size_t)M * DM, O_VP = O_KP + (size_t)MP * 512, O_KS = O_VP + (size_t)MP * 512, O_VS = O_KS + (size_t)MS * 512, O_VC = O_VS + (size_t)MS * 512, O_END = O_VC + (size_t)MS * 512;
constexpr size_t MiB = 1u << 20;
constexpr size_t WS_CTL = 0, CTL_ZERO_BYTES = 1 * MiB;
constexpr size_t WS_WIN = 2 * MiB, WS_WO = 8 * MiB, WS_WGU = 10 * MiB, WS_WD = 22 * MiB, WS_WS = 28 * MiB;
constexpr size_t WS_XN = 32 * MiB, WS_U = 66 * MiB, WS_GV = 83 * MiB, WS_Q = 100 * MiB, WS_K = 117 * MiB, WS_V = 134 * MiB, WS_MIX = 152 * MiB, WS_X1B = 186 * MiB, WS_H = 220 * MiB, WS_END = 312 * MiB;
static_assert(WS_WIN + (size_t)NIN * DM * 2 <= WS_WO && WS_WGU + (size_t)NGU * DM * 2 <= WS_WD && WS_WD + (size_t)DM * DFF * 2 <= WS_WS && WS_XN + (size_t)M * DM * 2 <= WS_U && WS_U + (size_t)M * 512 * 2 <= WS_GV &&
              WS_MIX + (size_t)M * DM * 2 <= WS_X1B && WS_X1B + (size_t)M * DM * 2 <= WS_H && WS_H + (size_t)M * DFF * 2 <= WS_END, "d_ws map");
constexpr int CW_TMO = 0, CW_CODE = 1, CW_QUEUE = 64, CW_BAR = 4096, CW_ST1 = 16384, CW_ST2 = CW_ST1 + M, CW_SS = CW_ST2 + M, CW_END = CW_SS + M;
static_assert(CW_END * 4 <= (int)CTL_ZERO_BYTES, "CTL words inside the memset region");
static_assert(pg8::EW_U == WS_U && pg8::EW_GV == WS_GV && pg8::EW_Q == WS_Q && pg8::EW_K == WS_K && pg8::EW_V == WS_V && pg8::EW_X1B == WS_X1B && pg8::EW_H == WS_H && pg8::EC_ST1 == CW_ST1 && pg8::EC_ST2 == CW_ST2 && pg8::EC_SS == CW_SS && pg8::EO_KP == O_KP && pg8::EO_VP == O_VP && pg8::EO_KS == O_KS && pg8::EO_VS == O_VS && WS_CTL == 0, "epilogue constants match the maps");
constexpr int RING_OFF = 0, RING_BYTES = 131072;
constexpr int LDSCTL_OFF = RING_BYTES, MISC_OFF = LDSCTL_OFF + 320, RED_OFF = RING_BYTES + 1024;
constexpr int LDS_BYTES = 147456;
static_assert(RED_OFF + 4096 + 8192 <= LDS_BYTES, "LDS map");

#define GAS __attribute__((address_space(1)))
#define LAS __attribute__((address_space(3)))
typedef unsigned short bf16;
typedef unsigned v4u __attribute__((ext_vector_type(4)));
typedef unsigned v2u __attribute__((ext_vector_type(2)));
typedef float f32x4 __attribute__((ext_vector_type(4)));
typedef float f32x16 __attribute__((ext_vector_type(16)));
typedef short bf16x8 __attribute__((ext_vector_type(8)));
typedef short v4i16_t __attribute__((ext_vector_type(4)));
typedef GAS unsigned gu32;
#define RLX_AGENT __ATOMIC_RELAXED, __HIP_MEMORY_SCOPE_AGENT
#define LDS_WAIT() asm volatile("s_waitcnt lgkmcnt(0)" ::: "memory")
#define VM_WAIT() asm volatile("s_waitcnt vmcnt(0)" ::: "memory")
__device__ __forceinline__ unsigned f2bf(float f) { unsigned u = __builtin_bit_cast(unsigned, f); return (u + 0x7fffu + ((u >> 16) & 1u)) >> 16; }
__device__ __forceinline__ unsigned pk2(float lo, float hi) { return pg8::cvt_pk_bf16(lo, hi); }
__device__ __forceinline__ float bf_lo(unsigned w) { return __builtin_bit_cast(float, w << 16); }
__device__ __forceinline__ float bf_hi(unsigned w) { return __builtin_bit_cast(float, w & 0xffff0000u); }
__device__ __forceinline__ float bf2f(bf16 b) { return __builtin_bit_cast(float, (unsigned)b << 16); }

#define XB_TMO      128
#define XB_XCNT(j)  (256  + 64 * (j))
#define XB_XSUB(j)  (1280 + 64 * (j))
#define XB_XGEN(j)  (2304 + 64 * (j))
#define XB_TOP      3328
#define XB_TOPGEN   3392
#define XCD_BAR_WORDS 3456
#define XB_SPIN_CAP (1u << 18)

__device__ __forceinline__ unsigned xb_ld(unsigned* p)              { return __hip_atomic_load(p, __ATOMIC_RELAXED, __HIP_MEMORY_SCOPE_AGENT); }
__device__ __forceinline__ unsigned xb_add(unsigned* p, unsigned v) { return __hip_atomic_fetch_add(p, v, __ATOMIC_RELAXED, __HIP_MEMORY_SCOPE_AGENT); }
__device__ __forceinline__ unsigned xb_xcc_id() { return (unsigned)__builtin_amdgcn_s_getreg((3 << 11) | 20) & 0xFu; }
#define XB_SPIN(cond, bar) do { unsigned _sp = 0; while (cond) { __builtin_amdgcn_s_sleep(1); \
    if ((++_sp & 255u) == 0u) { if (xb_ld(&(bar)[XB_TMO])) break; if (_sp > XB_SPIN_CAP) { atomicAdd(&(bar)[XB_TMO], 1u); break; } } } } while (0)

struct XcdBarrier {
    unsigned* bar; unsigned x;
    volatile LAS unsigned* st;
};

__device__ __forceinline__ XcdBarrier xcd_barrier_post(unsigned* bar, volatile LAS unsigned* st) {
    XcdBarrier b; b.bar = bar; b.x = xb_xcc_id(); b.st = st;
    if (threadIdx.x == 0) (void)xb_add(&bar[XB_XCNT(b.x)], 1u);
    return b;
}
__device__ __forceinline__ void xcd_barrier_complete(unsigned* bar, unsigned x, unsigned& nloc, unsigned& nx) {
    const unsigned G = gridDim.x * gridDim.y * gridDim.z;
    unsigned sum, cnt, mine, sp = 0u;
    for (;;) {
        sum = 0u; cnt = 0u; mine = 0u;
#pragma unroll
        for (unsigned j = 0; j < 16; ++j) { const unsigned c = xb_ld(&bar[XB_XCNT(j)]); sum += c; cnt += (c > 0u) ? 1u : 0u; mine = (j == x) ? c : mine; }
        if (sum == G) break;
        __builtin_amdgcn_s_sleep(1);
        if ((++sp & 255u) == 0u) { if (xb_ld(&bar[XB_TMO])) break; if (sp > XB_SPIN_CAP) { atomicAdd(&bar[XB_TMO], 1u); break; } }
    }
    nloc = mine > 0u ? mine : 1u; nx = cnt > 0u ? cnt : 1u;
}

__device__ __forceinline__ void xcd_barrier(const XcdBarrier& b) {
    asm volatile("s_waitcnt vmcnt(0)" ::: "memory");
    __syncthreads();
    if (threadIdx.x == 0) {
        unsigned* bar = b.bar;
        __builtin_amdgcn_s_waitcnt(0);
        unsigned nloc = b.st[0], nx = b.st[1];
        if (nloc == 0u) { xcd_barrier_complete(bar, b.x, nloc, nx); b.st[0] = nloc; b.st[1] = nx; }
        const unsigned old = xb_add(&bar[XB_XSUB(b.x)], 1u);
        const unsigned gen = old / nloc;
        if (old + 1u == (gen + 1u) * nloc) {
            __builtin_amdgcn_fence(__ATOMIC_RELEASE, "agent");
            asm volatile("s_waitcnt vmcnt(0)" ::: "memory");
            const unsigned og = xb_add(&bar[XB_TOP], 1u);
            const unsigned tg = og / nx;
            if (og + 1u == (tg + 1u) * nx) xb_add(&bar[XB_TOPGEN], 1u);
            else XB_SPIN(xb_ld(&bar[XB_TOPGEN]) == tg, bar);
            __builtin_amdgcn_fence(__ATOMIC_ACQUIRE, "agent");
            xb_add(&bar[XB_XGEN(b.x)], 1u);
            asm volatile("s_waitcnt vmcnt(0)" ::: "memory");
        } else {
            XB_SPIN(xb_ld(&bar[XB_XGEN(b.x)]) == gen, bar);
            __builtin_amdgcn_fence(__ATOMIC_ACQUIRE, "agent");
            asm volatile("s_waitcnt vmcnt(0)" ::: "memory");
        }
    }
    __syncthreads();
}
struct Args { const float* in[19]; float* out; unsigned char* ws; int ph_lo, ph_hi; };
struct Frame {
    LAS unsigned char* lds;
    volatile LAS unsigned* MISC;
    gu32* ctl;
    int tid, lane, wave;
    int vcu, G;
    unsigned char* ws; float* out;
};

__device__ __forceinline__ float wave_sum(float v) {
#pragma unroll
    for (int o = 1; o < 64; o <<= 1) v += __shfl_xor(v, o);
    return v;
}
__device__ __forceinline__ float wave_max(float v) {
#pragma unroll
    for (int o = 1; o < 64; o <<= 1) v = fmaxf(v, __shfl_xor(v, o));
    return v;
}
__device__ __forceinline__ void p0_transpose_item(const float* W, int K, int N, bf16* WT, int drow0, const float* kscale, LAS float* scr, int k0, int n0, int lane) {
#pragma unroll
    for (int i = 0; i < 32; ++i) { const int kk = 2 * i + (lane >> 5); float w = W[(size_t)(k0 + kk) * N + n0 + (lane & 31)]; if (kscale) w *= kscale[k0 + kk]; scr[kk * 33 + (lane & 31)] = w; }
    LDS_WAIT(); asm volatile("" ::: "memory");
    const int c = lane & 7;
#pragma unroll
    for (int j = 0; j < 4; ++j) { const int n = (lane >> 3) + 8 * j; const LAS float* s = scr + (8 * c) * 33 + n;
        v4u o; o.x = pk2(s[0 * 33], s[1 * 33]); o.y = pk2(s[2 * 33], s[3 * 33]); o.z = pk2(s[4 * 33], s[5 * 33]); o.w = pk2(s[6 * 33], s[7 * 33]);
        *(GAS v4u*)((GAS char*)WT + pg8::img_off_b(drow0 + n, k0 + 8 * c, K >> 6)) = o; }
    LDS_WAIT(); asm volatile("" ::: "memory");
}
__device__ __forceinline__ int win_drow(int n0) { const int sec = n0 >> 9; if (sec < 2) return n0; const int cs = n0 & 511, head = cs >> 6, dh = (cs >> 5) & 1; return 256 * (2 * sec + (head >> 2)) + 128 * dh + 32 * (head & 3); }
__device__ __forceinline__ void rms_row2_to_bf16(const float* xrow0, const float* xrow1, const float* g, bf16* obase, int orow, int lane) {
    const GAS f32x4* xr0 = (const GAS f32x4*)xrow0 + lane; const GAS f32x4* xr1 = (const GAS f32x4*)xrow1 + lane; const GAS f32x4* gr = (const GAS f32x4*)g + lane;
    f32x4 v0[4], v1[4]; float s0 = 0.f, s1 = 0.f;
#pragma unroll
    for (int j = 0; j < 4; ++j) { v0[j] = xr0[64 * j]; v1[j] = xr1[64 * j]; }
#pragma unroll
    for (int j = 0; j < 4; ++j) { s0 += (v0[j].x * v0[j].x + v0[j].y * v0[j].y) + (v0[j].z * v0[j].z + v0[j].w * v0[j].w); s1 += (v1[j].x * v1[j].x + v1[j].y * v1[j].y) + (v1[j].z * v1[j].z + v1[j].w * v1[j].w); }
    const float r0 = 1.f / sqrtf(wave_sum(s0) * (1.f / DM) + EPS), r1 = 1.f / sqrtf(wave_sum(s1) * (1.f / DM) + EPS);
#pragma unroll
    for (int j = 0; j < 4; ++j) { const f32x4 gg = gr[64 * j]; v2u o;
        o.x = pk2(v0[j].x * r0 * gg.x, v0[j].y * r0 * gg.y); o.y = pk2(v0[j].z * r0 * gg.z, v0[j].w * r0 * gg.w); *(GAS v2u*)((GAS char*)obase + pg8::img_off(orow, 4 * lane + 256 * j, DM / 64)) = o;
        o.x = pk2(v1[j].x * r1 * gg.x, v1[j].y * r1 * gg.y); o.y = pk2(v1[j].z * r1 * gg.z, v1[j].w * r1 * gg.w); *(GAS v2u*)((GAS char*)obase + pg8::img_off(orow + 1, 4 * lane + 256 * j, DM / 64)) = o; }
}
constexpr int I_IN = (DM / 64) * (NIN / 32), I_O = (DM / 64) * (DM / 32), I_G = (DM / 64) * (DFF / 32), I_D = (DFF / 64) * (DM / 32), I_LATE = I_O + 2 * I_G + I_D;
__device__ __forceinline__ void p0_late_item(Frame& F, const Args& A, LAS float* scr, int r) {
    if (r < I_O) { const int nblk = DM / 32, kb = r / nblk, nb = r % nblk; p0_transpose_item(A.in[14], DM, DM, ((bf16*)(F.ws + WS_WO)), 32 * nb, nullptr, scr, 64 * kb, 32 * nb, F.lane); return; } r -= I_O;
    if (r < 2 * I_G) { const bool up = r >= I_G; if (up) r -= I_G; const int nblk = DFF / 32, kb = r / nblk, nb = r % nblk, n0 = 32 * nb;
        p0_transpose_item(up ? A.in[17] : A.in[16], DM, DFF, ((bf16*)(F.ws + WS_WGU)), 256 * (n0 >> 7) + (up ? 128 : 0) + (n0 & 127), A.in[15], scr, 64 * kb, n0, F.lane); return; } r -= 2 * I_G;
    { const int nblk = DM / 32, kb = r / nblk, nb = r % nblk; p0_transpose_item(A.in[18], DFF, DM, ((bf16*)(F.ws + WS_WD)), 32 * nb, nullptr, scr, 64 * kb, 32 * nb, F.lane); }
}
__device__ __forceinline__ void p0_prologue(Frame& F, const Args& A) {
    LAS float* scr = (LAS float*)(F.lds + RING_OFF + F.wave * 16384);
    const int gw = F.vcu * NWAVES + F.wave, NGW = F.G * NWAVES;
    for (int r = gw; r < I_IN; r += NGW) { const int nblk = NIN / 32, kb = r / nblk, nb = r % nblk; p0_transpose_item(A.in[5], DM, NIN, ((bf16*)(F.ws + WS_WIN)), win_drow(32 * nb), nullptr, scr, 64 * kb, 32 * nb, F.lane); }
    for (int r = gw; r < I_LATE; r += NGW) p0_late_item(F, A, scr, r);
    for (int idx = gw; idx < 8 * 128; idx += NGW) { const int i = idx & 127;
#pragma unroll
        for (int q = 0; q < 2; ++q) { const int jj = F.lane + 64 * q; ((bf16*)(F.ws + WS_WS))[(size_t)idx * 128 + jj] = (jj <= i) ? (bf16)f2bf(A.in[8][(size_t)idx * 128 + jj]) : (bf16)0; } }
    for (int m = 2 * gw; m < M; m += 2 * NGW) {
        const float* x0 = (m < MP) ? A.in[0] + (size_t)m * DM : A.in[1] + (size_t)(m - MP) * DM; const float* x1 = (m + 1 < MP) ? A.in[0] + (size_t)(m + 1) * DM : A.in[1] + (size_t)(m + 1 - MP) * DM;
        rms_row2_to_bf16(x0, x1, A.in[4], ((bf16*)(F.ws + WS_XN)), m, F.lane); }
}
__device__ __forceinline__ float wgt(int delta, int qpos) {
    const int w = (delta <= 128 ? 1 : 0) + ((((delta & 3) == 0) && delta <= 512) ? 1 : 0) + ((((delta & 15) == 0) && delta <= 2048) ? 1 : 0);
    return ((unsigned)delta <= (unsigned)qpos) ? (float)w : 0.f;
}
__device__ __forceinline__ v4i16_t vtr(const LAS unsigned char* p) { return __builtin_amdgcn_ds_read_tr16_b64_v4i16((LAS v4i16_t*)p); }
__device__ __forceinline__ bf16x8 cat8(v4i16_t a, v4i16_t b) { return (bf16x8){a[0], a[1], a[2], a[3], b[0], b[1], b[2], b[3]}; }

struct KSet { bf16x8 kf[4]; };
__device__ __forceinline__ void a_tile_desc(int tt, int P0, int& kbase, int& stride) {
    if (tt < 6) { kbase = P0 - 2048 + 256 * tt; stride = 8; } else if (tt < 9) { kbase = P0 - 512 + 128 * (tt - 6); stride = 4; } else { kbase = P0 - 128 + 32 * (tt - 9); stride = 1; }
}
__device__ __forceinline__ void a_kstore(const v4u (&kv)[4], LAS unsigned char* slot, int lane) {
#pragma unroll
    for (int it = 0; it < 4; ++it) { const int row = (lane >> 3) + 8 * it; *(LAS v4u*)(slot + row * 128 + 16 * ((lane & 7) ^ ((row >> 1) & 7))) = kv[it]; }
}
__device__ __forceinline__ void a_kfrag(KSet& T, const LAS unsigned char* slot, int lane) {
    const int i = lane & 31, hi = lane >> 5, sw = (i >> 1) & 7;
#pragma unroll
    for (int kk = 0; kk < 4; ++kk) T.kf[kk] = *(const LAS bf16x8*)(slot + i * 128 + 16 * ((2 * kk + hi) ^ sw));
}
__device__ __forceinline__ void a_kvload(v4u (&kv)[4], v4u (&vv)[4], const bf16* Kh, const bf16* Vh, int tt, int P0, int lane) {
    int kbase, stride; a_tile_desc(tt > 20 ? 20 : tt, P0, kbase, stride);
    const int kp0 = kbase + stride * (lane >> 3), cb = 16 * (lane & 7);
#pragma unroll
    for (int it = 0; it < 4; ++it) { int kp = kp0 + 8 * stride * it; kp = kp < 0 ? 0 : (kp > SEQ - 1 ? SEQ - 1 : kp); const unsigned off = (unsigned)kp * 1024u + (unsigned)cb;
        kv[it] = *(const v4u*)((const char*)Kh + (size_t)off); vv[it] = *(const v4u*)((const char*)Vh + (size_t)off); }
}
__device__ __forceinline__ void a_vstore(const v4u (&vv)[4], LAS unsigned char* slot, int lane) {
#pragma unroll
    for (int it = 0; it < 4; ++it) *(LAS v4u*)(slot + ((lane >> 3) + 8 * it) * 128 + (lane & 7) * 16) = vv[it];
}
__device__ __forceinline__ f32x16 a_qk(const KSet& T, const bf16x8 (&qf)[4], float negb) {
    f32x16 s;
#pragma unroll
    for (int r = 0; r < 16; ++r) s[r] = negb;
#pragma unroll
    for (int kk = 0; kk < 4; ++kk) s = __builtin_amdgcn_mfma_f32_32x32x16_bf16(T.kf[kk], qf[kk], s, 0, 0, 0);
    return s;
}
template <int RANGE> __device__ __forceinline__ void a_periodic(float (&wp)[16], int P0, int qpos, int lane) {
    constexpr int ST = RANGE == 3 ? 8 : (RANGE == 2 ? 4 : 1);
    const int kb0 = RANGE == 3 ? P0 - 2048 : (RANGE == 2 ? P0 - 512 : P0 - 128);
    const int d0 = qpos - kb0 - ST * 4 * (lane >> 5);
#pragma unroll
    for (int r = 0; r < 16; ++r) { const int delta = d0 - ST * ((r & 3) + 8 * (r >> 2)); wp[r] = (RANGE == 1 ? (((delta & 3) == 0) ? 1.f : 0.f) : 0.f) + (((delta & 15) == 0) ? 1.f : 0.f); }
}
template <int RANGE>
__device__ __forceinline__ void a_softmax(f32x16 s, int tt, int P0, int qpos, int lane, const float (&wp)[16], bf16x8& pf0, bf16x8& pf1, float& lsum) {
    constexpr int ST = RANGE == 3 ? 8 : (RANGE == 2 ? 4 : 1);
    int kbase, stride; a_tile_desc(tt, P0, kbase, stride);
    const int hi = lane >> 5;
    const int d0 = qpos - kbase - ST * 4 * hi;
    const int lim3 = qpos < 2048 ? qpos : 2048;
    float ps = 0.f;
#pragma unroll
    for (int r = 0; r < 16; ++r) { const int delta = d0 - ST * ((r & 3) + 8 * (r >> 2)); float w;
        if (RANGE == 1) w = ((unsigned)delta <= (unsigned)qpos) ? wp[r] + (delta <= 128 ? 1.f : 0.f) : 0.f;
        else if (RANGE == 2) w = (delta <= qpos) ? wp[r] + (delta <= 512 ? 1.f : 0.f) : 0.f;
        else w = (delta <= lim3) ? wp[r] : 0.f;
        const float p = w * __builtin_amdgcn_exp2f(s[r]); ps += p; s[r] = p; }
    lsum += ps;
    v4u pa, pb; pa.x = pk2(s[0], s[1]); pa.y = pk2(s[2], s[3]); pa.z = pk2(s[4], s[5]); pa.w = pk2(s[6], s[7]); pb.x = pk2(s[8], s[9]); pb.y = pk2(s[10], s[11]); pb.z = pk2(s[12], s[13]); pb.w = pk2(s[14], s[15]);
    pf0 = __builtin_bit_cast(bf16x8, pa); pf1 = __builtin_bit_cast(bf16x8, pb);
}
__device__ __forceinline__ void a_pv(const bf16x8 pf0, const bf16x8 pf1, int lane, const LAS unsigned char* slot, f32x16& o0, f32x16& o1) {
    const int ii = lane & 15, hi = lane >> 5;
    const LAS unsigned char* vb = slot + (4 * hi + (ii >> 2)) * 128 + (16 * ((lane >> 4) & 1) + 4 * (ii & 3)) * 2;
    { const bf16x8 v00 = cat8(vtr(vb), vtr(vb + 1024)), v01 = cat8(vtr(vb + 2048), vtr(vb + 2048 + 1024));
      const bf16x8 v10 = cat8(vtr(vb + 64), vtr(vb + 64 + 1024)), v11 = cat8(vtr(vb + 64 + 2048), vtr(vb + 64 + 2048 + 1024));
      o0 = __builtin_amdgcn_mfma_f32_32x32x16_bf16(v00, pf0, o0, 0, 0, 0); o0 = __builtin_amdgcn_mfma_f32_32x32x16_bf16(v01, pf1, o0, 0, 0, 0);
      o1 = __builtin_amdgcn_mfma_f32_32x32x16_bf16(v10, pf0, o1, 0, 0, 0); o1 = __builtin_amdgcn_mfma_f32_32x32x16_bf16(v11, pf1, o1, 0, 0, 0); }
}
struct ASeq { int t, n1, n2, n3, ord, f2, f1; };
__device__ __forceinline__ int a_next(int tt, int f2, int f1) { int u = tt + 1; if (u == 6) u = 6 + f2; if (u == 9) u = 9 + f1; return u; }
__device__ __forceinline__ void a_step(ASeq& Q, v4u (&kv)[4], v4u (&vv)[4], f32x16& s_cur, int& wrange, float (&wp)[16], const bf16* Kh, const bf16* Vh, int P0, int qpos, int lane, const bf16x8 (&qf)[4], float negb,
                                       LAS unsigned char* vt, f32x16& o0, f32x16& o1, float& lsum) {
    LAS unsigned char* kslot = vt + 8192 + ((Q.ord + 1) & 1) * 4096;
    a_kstore(kv, kslot, lane); a_vstore(vv, vt + ((Q.ord + 1) & 1) * 4096, lane);
    a_kvload(kv, vv, Kh, Vh, Q.n3, P0, lane);
    f32x16 s_next; { KSet KA; a_kfrag(KA, kslot, lane); s_next = a_qk(KA, qf, negb); }
    const int range = Q.t < 6 ? 3 : (Q.t < 9 ? 2 : 1);
    if (range != wrange) { wrange = range; if (range == 3) a_periodic<3>(wp, P0, qpos, lane); else if (range == 2) a_periodic<2>(wp, P0, qpos, lane); else a_periodic<1>(wp, P0, qpos, lane); }
    bf16x8 pf0, pf1;
    if (range == 3) a_softmax<3>(s_cur, Q.t, P0, qpos, lane, wp, pf0, pf1, lsum);
    else if (range == 2) a_softmax<2>(s_cur, Q.t, P0, qpos, lane, wp, pf0, pf1, lsum);
    else a_softmax<1>(s_cur, Q.t, P0, qpos, lane, wp, pf0, pf1, lsum);
    a_pv(pf0, pf1, lane, vt + (Q.ord & 1) * 4096, o0, o1);
    s_cur = s_next;
    Q.t = Q.n1; Q.n1 = Q.n2; Q.n2 = Q.n3; Q.n3 = a_next(Q.n3, Q.f2, Q.f1); ++Q.ord;
}
__device__ __forceinline__ void unitA(Frame& F, const Args& A, int ua, float negb) {
    const int b = ua >> 6, g = (ua >> 3) & 7, r = ua & 7;
    int lane = (int)threadIdx.x & 63; asm volatile("" : "+v"(lane));
    const int h = F.wave, i = lane & 31, hi = lane >> 5;
    const int P0 = 256 * g + r, qpos = P0 + 8 * i;
    const size_t rowb = (size_t)b * SEQ;
    const bf16* Qp = ((bf16*)(F.ws + WS_Q)) + (rowb + qpos) * 512 + 64 * h + 8 * hi;
    bf16x8 qf[4];
#pragma unroll
    for (int kk = 0; kk < 4; ++kk) qf[kk] = *(const bf16x8*)(Qp + 16 * kk);
    const bf16* Kh = ((bf16*)(F.ws + WS_K)) + rowb * 512 + 64 * h; const bf16* Vh = ((bf16*)(F.ws + WS_V)) + rowb * 512 + 64 * h;
    LAS unsigned char* vt = F.lds + RING_OFF + h * 16384;
    f32x16 o0, o1;
#pragma unroll
    for (int q = 0; q < 16; ++q) { o0[q] = 0.f; o1[q] = 0.f; }
    float lsum = 0.f;
    int f3 = 0, f2 = 0, f1 = 0;
    while (f3 < 6 && P0 - 2048 + 256 * f3 + 248 < 0) ++f3;
    while (f2 < 3 && P0 - 512 + 128 * f2 + 124 < 0) ++f2;
    while (f1 < 12 && P0 - 128 + 32 * f1 + 31 < 0) ++f1;
    ASeq Q; Q.f2 = f2; Q.f1 = f1; Q.ord = 0;
    Q.t = f3 < 6 ? f3 : (f2 < 3 ? 6 + f2 : 9 + f1); Q.n1 = a_next(Q.t, f2, f1); Q.n2 = a_next(Q.n1, f2, f1); Q.n3 = a_next(Q.n2, f2, f1);
    v4u kv[4], vv[4], kw[4], vw[4];
    a_kvload(kv, vv, Kh, Vh, Q.t, P0, lane);
    a_kstore(kv, vt + 8192, lane); a_vstore(vv, vt, lane);
    a_kvload(kv, vv, Kh, Vh, Q.n1, P0, lane); a_kvload(kw, vw, Kh, Vh, Q.n2, P0, lane);
    f32x16 s_cur; { KSet K0; a_kfrag(K0, vt + 8192, lane); s_cur = a_qk(K0, qf, negb); }
    const int ntile = (6 - f3) + (3 - f2) + (12 - f1);
    int wrange = 0; float wp[16];
#pragma unroll
    for (int q = 0; q < 16; ++q) wp[q] = 0.f;
#pragma unroll 1
    for (int k = 0; k + 1 < ntile; k += 2) { a_step(Q, kv, vv, s_cur, wrange, wp, Kh, Vh, P0, qpos, lane, qf, negb, vt, o0, o1, lsum); a_step(Q, kw, vw, s_cur, wrange, wp, Kh, Vh, P0, qpos, lane, qf, negb, vt, o0, o1, lsum); }
    if (ntile & 1) a_step(Q, kv, vv, s_cur, wrange, wp, Kh, Vh, P0, qpos, lane, qf, negb, vt, o0, o1, lsum);
    const float lt = lsum + __shfl_xor(lsum, 32), inv = 1.0f / lt;
    float ssq = 0.f;
#pragma unroll
    for (int q = 0; q < 16; ++q) { o0[q] *= inv; o1[q] *= inv; ssq += o0[q] * o0[q] + o1[q] * o1[q]; }
    ssq += __shfl_xor(ssq, 32);
    LAS float* RED = (LAS float*)(F.lds + RED_OFF);
    if (hi == 0) RED[h * 32 + i] = ssq;
    __syncthreads();
    float tot = 0.f;
#pragma unroll
    for (int w = 0; w < 8; ++w) tot += RED[w * 32 + i];
    const float rr = 1.0f / sqrtf(tot * (1.0f / 512.0f) + EPS);
    char* mixb = (char*)(F.ws + WS_MIX); const int mrow = (int)rowb + qpos;
#pragma unroll
    for (int db = 0; db < 2; ++db)
#pragma unroll
        for (int rq = 0; rq < 4; ++rq) { const int d0 = 32 * db + 8 * rq + 4 * hi; const f32x4 gg = *(const f32x4*)(A.in[13] + 64 * h + d0);
            const float a0 = (db ? o1[4 * rq] : o0[4 * rq]) * rr * gg.x, a1 = (db ? o1[4 * rq + 1] : o0[4 * rq + 1]) * rr * gg.y, a2 = (db ? o1[4 * rq + 2] : o0[4 * rq + 2]) * rr * gg.z, a3 = (db ? o1[4 * rq + 3] : o0[4 * rq + 3]) * rr * gg.w;
            v2u w; w.x = pk2(a0, a1); w.y = pk2(a2, a3); *(v2u*)(mixb + pg8::img_off(mrow, 512 + 64 * h + d0, DM / 64)) = w; }
    __syncthreads();
}

__device__ __forceinline__ void unitB(Frame& F, const Args& A, int ub) {
    int lane = (int)threadIdx.x & 63; asm volatile("" : "+v"(lane));
    const int h = F.wave, il = lane & 31, hi = lane >> 5;
    const size_t R0 = (size_t)ub * 128;
    LAS unsigned char* vn = F.lds + RING_OFF + h * 16384;
    { const int jl = lane >> 3, ch = lane & 7;
      f32x4 lg0 = *(const f32x4*)(A.in[6] + 64 * h + 8 * ch), lg1 = *(const f32x4*)(A.in[6] + 64 * h + 8 * ch + 4), lb0 = *(const f32x4*)(A.in[7] + 64 * h + 8 * ch), lb1 = *(const f32x4*)(A.in[7] + 64 * h + 8 * ch + 4);
#pragma unroll 4
      for (int it = 0; it < 16; ++it) { const int j = jl + 8 * it; const size_t row = R0 + j;
          const v4u gv = *(const v4u*)(((bf16*)(F.ws + WS_GV)) + row * 512 + 64 * h + 8 * ch);
          const float mu = __hip_atomic_load(((float*)F.ws + CW_ST1) + row, RLX_AGENT) * (1.0f / 512.0f), var = __hip_atomic_load(((float*)F.ws + CW_ST2) + row, RLX_AGENT) * (1.0f / 512.0f) - mu * mu, rstd = 1.0f / sqrtf(var + EPS);
          v4u o;
          o.x = pk2((bf_lo(gv.x) - mu) * rstd * lg0.x + lb0.x, (bf_hi(gv.x) - mu) * rstd * lg0.y + lb0.y); o.y = pk2((bf_lo(gv.y) - mu) * rstd * lg0.z + lb0.z, (bf_hi(gv.y) - mu) * rstd * lg0.w + lb0.w);
          o.z = pk2((bf_lo(gv.z) - mu) * rstd * lg1.x + lb1.x, (bf_hi(gv.z) - mu) * rstd * lg1.y + lb1.y); o.w = pk2((bf_lo(gv.w) - mu) * rstd * lg1.z + lb1.z, (bf_hi(gv.w) - mu) * rstd * lg1.w + lb1.w);
          *(LAS v4u*)(vn + j * 128 + ch * 16) = o; } }
    f32x16 acc[4][2];
#pragma unroll
    for (int ib = 0; ib < 4; ++ib)
#pragma unroll
        for (int db = 0; db < 2; ++db)
#pragma unroll
            for (int q = 0; q < 16; ++q) acc[ib][db][q] = 0.f;
    const int ii = lane & 15;
    const LAS unsigned char* vb = vn + (8 * hi + (ii >> 2)) * 128 + (16 * ((lane >> 4) & 1) + 4 * (ii & 3)) * 2;
    const bf16* Wh = ((bf16*)(F.ws + WS_WS)) + (size_t)h * 128 * 128 + (size_t)il * 128 + 8 * hi;
#pragma unroll
    for (int ib = 0; ib < 4; ++ib) {
        bf16x8 wf[8];
#pragma unroll
        for (int kk = 0; kk < 8; ++kk) if (kk < 2 * ib + 2) wf[kk] = *(const bf16x8*)(Wh + (size_t)ib * 32 * 128 + 16 * kk);
#pragma unroll
        for (int kk = 0; kk < 8; ++kk) if (kk < 2 * ib + 2) {
            const bf16x8 a0 = cat8(vtr(vb + kk * 2048), vtr(vb + kk * 2048 + 512)), a1 = cat8(vtr(vb + kk * 2048 + 64), vtr(vb + kk * 2048 + 64 + 512));
            acc[ib][0] = __builtin_amdgcn_mfma_f32_32x32x16_bf16(a0, wf[kk], acc[ib][0], 0, 0, 0); acc[ib][1] = __builtin_amdgcn_mfma_f32_32x32x16_bf16(a1, wf[kk], acc[ib][1], 0, 0, 0); }
        __builtin_amdgcn_sched_barrier(0);
    }
    LAS float* RED = (LAS float*)(F.lds + RED_OFF);
#pragma unroll
    for (int ib = 0; ib < 4; ++ib) { const size_t row = R0 + 32 * ib + il; const float bsi = A.in[9][h * 128 + 32 * ib + il]; float ssq = 0.f;
#pragma unroll
        for (int db = 0; db < 2; ++db)
#pragma unroll
            for (int rq = 0; rq < 4; ++rq) { const int d0 = 32 * db + 8 * rq + 4 * hi; const v2u uu = *(const v2u*)(((bf16*)(F.ws + WS_U)) + row * 512 + 64 * h + d0);
                float a0 = bf_lo(uu.x) * (acc[ib][db][4 * rq] + bsi), a1 = bf_hi(uu.x) * (acc[ib][db][4 * rq + 1] + bsi), a2 = bf_lo(uu.y) * (acc[ib][db][4 * rq + 2] + bsi), a3 = bf_hi(uu.y) * (acc[ib][db][4 * rq + 3] + bsi);
                acc[ib][db][4 * rq] = a0; acc[ib][db][4 * rq + 1] = a1; acc[ib][db][4 * rq + 2] = a2; acc[ib][db][4 * rq + 3] = a3; ssq += (a0 * a0 + a1 * a1) + (a2 * a2 + a3 * a3); }
        ssq += __shfl_xor(ssq, 32);
        if (hi == 0) RED[h * 128 + 32 * ib + il] = ssq; }
    __syncthreads();
#pragma unroll
    for (int ib = 0; ib < 4; ++ib) { const size_t row = R0 + 32 * ib + il; float tot = 0.f;
#pragma unroll
        for (int w = 0; w < 8; ++w) tot += RED[w * 128 + 32 * ib + il];
        const float rr = 1.0f / sqrtf(tot * (1.0f / 512.0f) + EPS);
        char* mixb = (char*)(F.ws + WS_MIX);
#pragma unroll
        for (int db = 0; db < 2; ++db)
#pragma unroll
            for (int rq = 0; rq < 4; ++rq) { const int d0 = 32 * db + 8 * rq + 4 * hi; const f32x4 gg = *(const f32x4*)(A.in[12] + 64 * h + d0);
                v2u w; w.x = pk2(acc[ib][db][4 * rq] * rr * gg.x, acc[ib][db][4 * rq + 1] * rr * gg.y); w.y = pk2(acc[ib][db][4 * rq + 2] * rr * gg.z, acc[ib][db][4 * rq + 3] * rr * gg.w); *(v2u*)(mixb + pg8::img_off((int)row, 64 * h + d0, DM / 64)) = w; } }
    __syncthreads();
}

template <int CTRL> __device__ __forceinline__ float dppf(float x) { return __builtin_bit_cast(float, __builtin_amdgcn_mov_dpp(__builtin_bit_cast(int, x), CTRL, 0xf, 0xf, true)); }
__device__ __forceinline__ float row16_sum(float v) { v += dppf<0xB1>(v); v += dppf<0x4E>(v); v += dppf<0x141>(v); v += dppf<0x128>(v); return v; }
__device__ __forceinline__ float dot4(f32x4 a, f32x4 b) { return (a.x * b.x + a.y * b.y) + (a.z * b.z + a.w * b.w); }
struct CState { f32x4 a[4]; float l[4]; };
__device__ __forceinline__ void c_row_t(const f32x4 k, const f32x4 v, int delta, const f32x4 qa, float negb, f32x4& a, float& l) {
    const float w = wgt(delta, 1 << 30);
    const float d = row16_sum(dot4(k, qa));
    const float p = w * __builtin_amdgcn_exp2f(d + negb);
    l += p; a += v * p;
}
struct CBuf { f32x4 k[8], v[8]; };
__device__ __forceinline__ void c_issue(CBuf& B, const float* kbase, const float* vbase, long rstride, int off) {
#pragma unroll
    for (int q = 0; q < 8; ++q) { B.k[q] = __builtin_nontemporal_load((const f32x4*)(kbase + (long)q * rstride + off)); B.v[q] = __builtin_nontemporal_load((const f32x4*)(vbase + (long)q * rstride + off)); }
}
__device__ __forceinline__ void c_consume(const CBuf& B, int delta0, int dstep, int tsel, const LAS float* qs, int off, float negb, CState& S) {
#pragma unroll
    for (int t = 0; t < 4; ++t) { if (tsel < 0 || tsel == t) {
        const f32x4 qa = *(const LAS f32x4*)(qs + t * 512 + off);
#pragma unroll
        for (int q = 0; q < 8; ++q) c_row_t(B.k[q], B.v[q], delta0 + q * dstep + t, qa, negb, S.a[t], S.l[t]); } }
}
__device__ __forceinline__ void c_desc(int b, int ws, long& idx, long& rstride, int& d0, int& dstep, int& tsel) {
    if (b < 4) { idx = LB - 128 + 32 * ws + 8 * b; rstride = 512; d0 = 128 - 32 * ws - 8 * b; dstep = -1; tsel = -1; }
    else { const int bb = b - 4, t = bb / 6, i = bb % 6, st = (i < 3) ? 4 : 16, j0 = 33 + 24 * ws + 8 * (i % 3); idx = LB + t - st * j0; rstride = -(long)st * 512; d0 = st * j0 - t; dstep = st; tsel = t; }
}
__device__ __forceinline__ void unitD(Frame& F, const Args& A, int n) {
    int tid = (int)threadIdx.x; asm volatile("" : "+v"(tid)); const int lane = tid & 63, w = F.wave;
    const size_t ms0 = (size_t)MP + 4 * n;
    LAS float* RED = (LAS float*)(F.lds + RED_OFF);
    {   const int col = tid, h = col >> 6;
        const float lg = A.in[6][col], lb = A.in[7][col];
        float vnv[4], a[4];
#pragma unroll
        for (int t = 0; t < 4; ++t) { const size_t row = ms0 + t; const float mu = __hip_atomic_load(((float*)F.ws + CW_ST1) + row, RLX_AGENT) * (1.0f / 512.0f), var = __hip_atomic_load(((float*)F.ws + CW_ST2) + row, RLX_AGENT) * (1.0f / 512.0f) - mu * mu, rstd = 1.0f / sqrtf(var + EPS);
            vnv[t] = (bf2f(((bf16*)(F.ws + WS_GV))[row * 512 + col]) - mu) * rstd * lg + lb; F.out[O_VC + (size_t)(4 * n + t) * 512 + col] = vnv[t]; }
#pragma unroll
        for (int i = 0; i < 4; ++i) { float s = A.in[9][h * 128 + i];
#pragma unroll
            for (int j = 0; j <= i; ++j) s += A.in[8][(size_t)(h * 128 + i) * 128 + j] * vnv[j];
            a[i] = bf2f(((bf16*)(F.ws + WS_U))[(ms0 + i) * 512 + col]) * s; const float sq = wave_sum(a[i] * a[i]); if (lane == 0) RED[w * 4 + i] = sq; }
        __syncthreads();
        const float go = A.in[12][col];
#pragma unroll
        for (int i = 0; i < 4; ++i) { float tot = 0.f;
#pragma unroll
            for (int ww = 0; ww < 8; ++ww) tot += RED[ww * 4 + i];
            *(bf16*)((char*)(F.ws + WS_MIX) + pg8::img_off((int)ms0 + i, col, DM / 64)) = (bf16)f2bf(a[i] * (1.0f / sqrtf(tot * (1.0f / 512.0f) + EPS)) * go); }
        __syncthreads();
    }
}
__device__ __forceinline__ void unitC(Frame& F, const Args& A, int n, float negb) {
    int tid = (int)threadIdx.x; asm volatile("" : "+v"(tid)); const int lane = tid & 63, w = F.wave;
    const size_t ms0 = (size_t)MP + 4 * n;
    LAS float* RED = (LAS float*)(F.lds + RED_OFF);
    CState S;
    const float* ck = A.in[2] + (size_t)n * LB * 512; const float* cv = A.in[3] + (size_t)n * LB * 512;
    const int half = w >> 2, ws = w & 3, off = 256 * half + 4 * lane;
    CBuf X, Y;
    { long idx, rs; int d0, ds, ts; c_desc(0, ws, idx, rs, d0, ds, ts); c_issue(X, ck + idx * 512, cv + idx * 512, rs, off); }
    LAS float* qs = (LAS float*)(F.lds + RING_OFF + 73728);
#pragma unroll
    for (int t = 0; t < 4; ++t) { qs[t * 512 + tid] = bf2f(((bf16*)(F.ws + WS_Q))[(ms0 + t) * 512 + tid]); S.a[t] = (f32x4){0.f, 0.f, 0.f, 0.f}; S.l[t] = 0.f; }
    __syncthreads();
#pragma unroll 1
    for (int b = 0; b < 28; b += 2) {
        long idx, rs; int d0, ds, ts, d1, ds1, ts1;
        c_desc(b + 1, ws, idx, rs, d1, ds1, ts1); c_issue(Y, ck + idx * 512, cv + idx * 512, rs, off);
        __builtin_amdgcn_sched_barrier(0);
        c_desc(b, ws, idx, rs, d0, ds, ts); c_consume(X, d0, ds, ts, qs, off, negb, S);
        __builtin_amdgcn_sched_barrier(0);
        if (b + 2 < 28) { c_desc(b + 2, ws, idx, rs, d0, ds, ts); c_issue(X, ck + idx * 512, cv + idx * 512, rs, off); }
        __builtin_amdgcn_sched_barrier(0);
        c_consume(Y, d1, ds1, ts1, qs, off, negb, S);
        __builtin_amdgcn_sched_barrier(0);
    }
    {   const f32x4 k = *(const f32x4*)(F.out + O_KS + (size_t)(4 * n + ws) * 512 + off), v = *(const f32x4*)(F.out + O_VS + (size_t)(4 * n + ws) * 512 + off);
#pragma unroll
        for (int t = 0; t < 4; ++t) { const f32x4 qa = *(const LAS f32x4*)(qs + t * 512 + off); c_row_t(k, v, t - ws, qa, negb, S.a[t], S.l[t]); } }
    LAS float* racc = (LAS float*)(F.lds + RING_OFF); LAS float* rl = (LAS float*)(F.lds + RING_OFF + 65536);
#pragma unroll
    for (int t = 0; t < 4; ++t) { *(LAS f32x4*)(racc + (ws * 4 + t) * 512 + off) = S.a[t]; if ((lane & 15) == 0) rl[(ws * 4 + t) * 8 + 4 * half + (lane >> 4)] = S.l[t]; }
    __syncthreads();
    {   const int col = tid, h = col >> 6; float o[4];
#pragma unroll
        for (int t = 0; t < 4; ++t) { float num = 0.f, den = 0.f;
#pragma unroll
            for (int ww = 0; ww < 4; ++ww) { num += racc[(ww * 4 + t) * 512 + col]; den += rl[(ww * 4 + t) * 8 + h]; }
            o[t] = num / den; const float sq = wave_sum(o[t] * o[t]); if (lane == 0) RED[w * 4 + t] = sq; }
        __syncthreads();
        const float go = A.in[13][col];
#pragma unroll
        for (int t = 0; t < 4; ++t) { float tot = 0.f;
#pragma unroll
            for (int ww = 0; ww < 8; ++ww) tot += RED[ww * 4 + t];
            *(bf16*)((char*)(F.ws + WS_MIX) + pg8::img_off((int)ms0 + t, 512 + col, DM / 64)) = (bf16)f2bf(o[t] * (1.0f / sqrtf(tot * (1.0f / 512.0f) + EPS)) * go); }
        __syncthreads();
    }
}
constexpr int NU_Q = 16 + 64 + 16 + 16;
static_assert(NDEC == 8 * 16 && NBATCH == 8, "queue split");
__device__ __forceinline__ void p2_mixers(Frame& F, const Args& A) {
    const float gqm = wave_max(fabsf(A.in[10][F.lane])), gkm = wave_max(fabsf(A.in[11][F.lane]));
    const float negb = __builtin_bit_cast(float, __builtin_amdgcn_readfirstlane(__builtin_bit_cast(int, -(8.0f * 1.4426950408889634f * 1.02f) * gqm * gkm)));
    const int myq = (int)(xb_xcc_id() & 7u);
#pragma unroll 1
    for (int qq = 0; qq < 8; ++qq) {
        const int q = (myq + qq) & 7;
        for (;;) {
            if (threadIdx.x == 0) F.MISC[0] = __hip_atomic_fetch_add(F.ctl + CW_QUEUE + 64 * q, 1u, RLX_AGENT);
            __syncthreads();
            const int k = (int)F.MISC[0];
            __syncthreads();
            if (k >= NU_Q) break;
            if (k < 16) unitC(F, A, 16 * q + k, negb);
            else if (k < 80) unitA(F, A, 64 * q + (k - 16), negb);
            else if (k < 96) unitB(F, A, 16 * q + (k - 80));
            else unitD(F, A, 16 * q + (k - 96));
        }
    }
}

template <int K, int MODE>
__device__ __forceinline__ void skinny_tile(Frame& F, const Args& A, const bf16* Am  , const bf16* Bt  ) {
    int lane = (int)threadIdx.x & 63; asm volatile("" : "+v"(lane));
    const int w = F.wave, il = lane & 31, hi = lane >> 5;
    for (int tile = (int)blockIdx.x; tile < 256; tile += (int)gridDim.x) {
    const int r0 = 64 * (tile >> 5), c0 = 32 * (tile & 31);
    constexpr int KW = K / 8, NK = KW / 16;
    const char* ab = (const char*)Am; const char* bb = (const char*)Bt; const int arow = MP + r0 + il, brow = c0 + il, kc0 = w * KW + 8 * hi;
    f32x16 acc0, acc1;
#pragma unroll
    for (int q = 0; q < 16; ++q) { acc0[q] = 0.f; acc1[q] = 0.f; }
    constexpr int CH = (NK % 8 == 0) ? 8 : 11;
    static_assert(NK % CH == 0, "skinny_tile: K slice");
#pragma unroll 1
    for (int k0 = 0; k0 < NK; k0 += CH) {
        bf16x8 bf[CH], a0[CH], a1[CH];
#pragma unroll
        for (int c = 0; c < CH; ++c) { const int kc = kc0 + 16 * (k0 + c); bf[c] = *(const bf16x8*)(bb + pg8::img_off_b(brow, kc, K / 64)); a0[c] = *(const bf16x8*)(ab + pg8::img_off(arow, kc, K / 64)); a1[c] = *(const bf16x8*)(ab + pg8::img_off(arow + 32, kc, K / 64)); }
#pragma unroll
        for (int c = 0; c < CH; ++c) { acc0 = __builtin_amdgcn_mfma_f32_32x32x16_bf16(bf[c], a0[c], acc0, 0, 0, 0); acc1 = __builtin_amdgcn_mfma_f32_32x32x16_bf16(bf[c], a1[c], acc1, 0, 0, 0); }
    }
    LAS float* red = (LAS float*)(F.lds + RING_OFF);
#pragma unroll
    for (int q = 0; q < 16; ++q) { red[((w * 2 + 0) * 16 + q) * 64 + lane] = acc0[q]; red[((w * 2 + 1) * 16 + q) * 64 + lane] = acc1[q]; }
    __syncthreads();
    const int rb = w >> 2, qg = w & 3;
    f32x4 v = (f32x4){0.f, 0.f, 0.f, 0.f};
#pragma unroll
    for (int ww = 0; ww < 8; ++ww)
#pragma unroll
        for (int j = 0; j < 4; ++j) v[j] += red[((ww * 2 + rb) * 16 + 4 * qg + j) * 64 + lane];
    const int srow = r0 + 32 * rb + il, col = c0 + 8 * qg + 4 * hi;
    float* yp = F.out + O_Y + (size_t)(MP + srow) * DM + col;
    if (MODE == 0) {
        const f32x4 x = *(const f32x4*)(A.in[1] + (size_t)srow * DM + col); v = v + x;
        v2u o; o.x = pk2(v[0], v[1]); o.y = pk2(v[2], v[3]); *(v2u*)((char*)(F.ws + WS_X1B) + pg8::img_off(MP + srow, col, DM / 64)) = o;
        float s = (v[0] * v[0] + v[1] * v[1]) + (v[2] * v[2] + v[3] * v[3]); s += __shfl_xor(s, 32);
        if (hi == 0) atomicAdd((float*)F.ws + CW_SS + MP + srow, s);
    } else {
        const v2u xb = *(const v2u*)((const char*)(F.ws + WS_X1B) + pg8::img_off(MP + srow, col, DM / 64)); *(f32x4*)yp = v + (f32x4){bf_lo(xb.x), bf_hi(xb.x), bf_lo(xb.y), bf_hi(xb.y)};
    }
    __syncthreads();
    }
}
__global__ void __launch_bounds__(NWAVES * 64, 2) hymba_fwd(Args args) {
    extern __shared__ __attribute__((aligned(16))) unsigned char lds[];
    Frame F;
    F.lds = (LAS unsigned char*)lds;
    F.MISC = (volatile LAS unsigned*)(F.lds + MISC_OFF);
    F.tid = threadIdx.x; F.lane = F.tid & 63; F.wave = __builtin_amdgcn_readfirstlane(F.tid >> 6);
    F.G = gridDim.x; { const int bx = blockIdx.x; F.vcu = (F.G % 8 == 0) ? (bx % 8) * (F.G / 8) + bx / 8 : bx; }
    unsigned char* ws = args.ws;
    F.ctl = (gu32*)(ws + WS_CTL); F.ws = ws; F.out = args.out;
    for (int u = F.tid; u < (LDS_BYTES - LDSCTL_OFF) / 4; u += NWAVES * 64) ((LAS unsigned*)(F.lds + LDSCTL_OFF))[u] = 0u;
    __syncthreads();
    XcdBarrier bar; bar.bar = (unsigned*)(F.ctl + CW_BAR); bar.x = 0; bar.st = nullptr;
    if (N_LAUNCHES != PER_PHASE) bar = xcd_barrier_post((unsigned*)(F.ctl + CW_BAR), F.MISC + 8);
#define GRID_BAR(seam) do { if (N_LAUNCHES == PER_PHASE) { if (F.tid == 0) __hip_atomic_store(F.ctl + CW_TMO, 0xBADBA0u | (unsigned)(seam), RLX_AGENT); } else { xcd_barrier(bar); } } while (0)
    const int lo = args.ph_lo, hi = args.ph_hi;
#define IN(k) (lo <= (k) && (k) < hi)
#define BOTH(k) (IN(k) && IN((k) + 1))
    if (IN(0)) { p0_prologue(F, args); if (BOTH(0)) GRID_BAR(0); }
    if (IN(1)) {
        pg8::Gemm g{(const bf16*)(ws + WS_XN), (const bf16*)(ws + WS_WIN), M, NIN, DM}; pg8::StaticOrder S; S.init(M, NIN, F.G, (int)blockIdx.x);
        pg8::EpiIn E{ws, args.out, args.in[10], args.in[11]};
        pg8::gemm_phase<pg8::EpiIn, pg8::StaticOrder, PG8_ALIGN, PG8_SP2>(F.lds + RING_OFF, g, S, E);
        if (BOTH(1)) GRID_BAR(1);
    }
    if (IN(2)) { p2_mixers(F, args); if (BOTH(2)) GRID_BAR(2); }
    if (IN(3)) {
        pg8::Gemm g{(const bf16*)(ws + WS_MIX), (const bf16*)(ws + WS_WO), MP, DM, DM}; pg8::StaticOrder S; S.init(MP, DM, F.G, (int)blockIdx.x);
        pg8::EpiWo E{args.in[0], args.in[1], args.out, ws};
        pg8::gemm_phase<pg8::EpiWo, pg8::StaticOrder, PG8_ALIGN, PG8_SP2>(F.lds + RING_OFF, g, S, E);
        skinny_tile<DM, 0>(F, args, (const bf16*)(ws + WS_MIX), (const bf16*)(ws + WS_WO));
        if (BOTH(3)) GRID_BAR(3);
    }
    if (IN(4)) {
        pg8::Gemm g{(const bf16*)(ws + WS_X1B), (const bf16*)(ws + WS_WGU), M, NGU, DM}; pg8::StaticOrder S; S.init(M, NGU, F.G, (int)blockIdx.x);
        pg8::EpiGU E{ws};
        pg8::gemm_phase<pg8::EpiGU, pg8::StaticOrder, PG8_ALIGN, PG8_SP2>(F.lds + RING_OFF, g, S, E);
        if (BOTH(4)) GRID_BAR(4);
    }
    if (IN(5)) {
        pg8::Gemm g{(const bf16*)(ws + WS_H), (const bf16*)(ws + WS_WD), MP, DM, DFF}; pg8::StaticOrder S; S.init(MP, DM, F.G, (int)blockIdx.x);
        pg8::EpiDown E{args.out, ws};
        pg8::gemm_phase<pg8::EpiDown, pg8::StaticOrder, PG8_ALIGN, PG8_SP2>(F.lds + RING_OFF, g, S, E);
        skinny_tile<DFF, 1>(F, args, (const bf16*)(ws + WS_H), (const bf16*)(ws + WS_WD));
    }
#undef IN
#undef BOTH
}

extern "C" void kernel_launch(void* const* d_in, const int* in_sizes, int n_in, void* d_out, int out_size, void* d_ws, size_t ws_size, hipStream_t stream) {
    static int grid = 0;
    if (grid == 0) {
        if (n_in != 19 || in_sizes[0] != MP * DM || in_sizes[1] != MS * DM || (size_t)out_size != O_END || ws_size < WS_END) { fprintf(stderr, "kernel_launch: unexpected shapes (n_in %d, in0 %d, out %d, ws %zu); nothing launched\n", n_in, n_in > 0 ? in_sizes[0] : -1, out_size, ws_size); grid = -1; return; }
        int dev = 0, cus = 0, per_cu = 0;
        if (hipGetDevice(&dev) != hipSuccess || hipDeviceGetAttribute(&cus, hipDeviceAttributeMultiprocessorCount, dev) != hipSuccess) { grid = -1; return; }
        if (hipFuncSetAttribute((const void*)hymba_fwd, hipFuncAttributeMaxDynamicSharedMemorySize, LDS_BYTES) != hipSuccess) { fprintf(stderr, "kernel_launch: hipFuncSetAttribute failed\n"); grid = -1; return; }
        if (hipOccupancyMaxActiveBlocksPerMultiprocessor(&per_cu, (const void*)hymba_fwd, NWAVES * 64, LDS_BYTES) != hipSuccess || per_cu < 1) fprintf(stderr, "kernel_launch: occupancy query reports %d\n", per_cu);
        (void)hipGetLastError();
        grid = cus;
    }
    if (grid < 0) return;
    if (hipMemsetAsync((char*)d_ws + WS_CTL, 0, CTL_ZERO_BYTES, stream) != hipSuccess) { fprintf(stderr, "kernel_launch: hipMemsetAsync failed\n"); return; }
    Args a{};
    for (int i = 0; i < 19; ++i) a.in[i] = (const float*)d_in[i];
    a.out = (float*)d_out; a.ws = (unsigned char*)d_ws;
    for (int li = 0; li < N_LAUNCHES; ++li) {
        a.ph_lo = (N_LAUNCHES == PER_PHASE) ? li : 0; a.ph_hi = (N_LAUNCHES == PER_PHASE) ? li + 1 : PER_PHASE;
        hipLaunchKernelGGL(hymba_fwd, dim3(grid), dim3(NWAVES * 64), LDS_BYTES, stream, a);
        const hipError_t le = hipPeekAtLastError();
        if (le != hipSuccess) { fprintf(stderr, "kernel_launch: launch %d failed: %s\n", li, hipGetErrorName(le)); break; }
    }
}
```

```cpp
#include <hip/hip_runtime.h>
#include <cstdio>
#include <cstdint>
namespace pg8 {
#define PG8_LAS __attribute__((address_space(3)))
typedef unsigned short bf16_t;
typedef short bf16x8 __attribute__((ext_vector_type(8)));
typedef float f32x4 __attribute__((ext_vector_type(4)));
typedef unsigned u32x4 __attribute__((ext_vector_type(4)));
constexpr int BM = 256, BK = 64, HALF = 128, HTB = HALF * BK * 2  , STAGE_BYTES = 8 * HTB, NXCD = 8, WGM = 8;

__host__ __device__ __forceinline__ int lds_byte(int r, int c) { const int st = (r >> 4) * 2 + (c >> 5), rr = r & 15, cc = c & 31, ob = rr * 64 + cc * 2; return st * 1024 + (ob ^ (((ob >> 9) & 1) << 5)); }
__host__ __device__ __forceinline__ void stage_rc(int b, int& R, int& C) { const int st = b / 1024, sb = b % 1024, swz = sb ^ (((sb >> 9) & 1) << 5); R = (st >> 1) * 16 + swz / 64; C = (st & 1) * 32 + (swz % 64) / 2; }
__host__ __device__ __forceinline__ int perm32(int rho) { const int n = rho >> 4, i = rho & 15; return 8 * (i >> 2) + 4 * n + (i & 3); }

__host__ __device__ __forceinline__ int invperm32(int x) { return 16 * ((x >> 2) & 1) + 4 * (x >> 3) + (x & 3); }
__host__ __device__ __forceinline__ size_t img_off(int row, int col, int nkt) { return ((size_t)((row >> 7) * nkt + (col >> 6)) << 14) + (size_t)lds_byte(row & 127, col & 63); }
__host__ __device__ __forceinline__ size_t img_off_b(int row, int col, int nkt) { return img_off((row & ~31) | invperm32(row & 31), col, nkt); }
struct Unit { int pm, pn; };
struct Gemm { const bf16_t* A; const bf16_t* Bt; int M, N, K; };

struct StaticOrder {
    int nM, nN, nwg, G, c;
    __host__ __device__ void init(int M, int N, int G_, int c_) { nM = M / BM; nN = N / BM; nwg = nM * nN; G = G_; c = c_; }
    __host__ __device__ bool next(int i, Unit& u) const {
        const long L = (long)i * G + c; if (L >= nwg) return false;
        int wgid = (int)L; { const int q = nwg / NXCD, r = nwg % NXCD, xcd = wgid % NXCD, off = wgid / NXCD; wgid = (xcd < r ? xcd * (q + 1) : r * (q + 1) + (xcd - r) * q) + off; }
        const int nig = WGM * nN, gid = wgid / nig, fm = gid * WGM, gsz = (nM - fm) < WGM ? (nM - fm) : WGM;
        u.pm = fm + ((wgid % nig) % gsz); u.pn = (wgid % nig) / gsz; return true;
    }
    __device__ __forceinline__ void a_ready(const Unit&) const {}
    __device__ __forceinline__ void done(const Unit&) const {}
};

__device__ __forceinline__ unsigned cvt_pk_bf16(float lo, float hi) { unsigned r; asm volatile("v_cvt_pk_bf16_f32 %0, %1, %2" : "=v"(r) : "v"(lo), "v"(hi)); return r; }
typedef float f32x2 __attribute__((ext_vector_type(2)));
__device__ __forceinline__ float fast_exp2(float x) { return __builtin_amdgcn_exp2f(x); }
__device__ __forceinline__ float fast_rcp(float x) { return __builtin_amdgcn_rcpf(x); }
__device__ __forceinline__ float gelu_t(float x) { const float u = 0.7978845608028654f * (x + 0.044715f * x * x * x); return x * fast_rcp(1.0f + fast_exp2(-2.8853900817779268f * u)); }
__device__ __forceinline__ float silu_f(float x) { return x * fast_rcp(1.0f + fast_exp2(-1.4426950408889634f * x)); }
__device__ __forceinline__ float quad_sum(float s) { s += __shfl_xor(s, 16); s += __shfl_xor(s, 32); return s; }

constexpr size_t EW_U = 66u << 20, EW_GV = 83u << 20, EW_Q = 100u << 20, EW_K = 117u << 20, EW_V = 134u << 20, EW_X1B = 186u << 20, EW_H = 220u << 20;
constexpr int EC_ST1 = 16384, EC_ST2 = EC_ST1 + 16896, EC_SS = EC_ST2 + 16896, EC_RS = EC_SS + 16896;
constexpr size_t EW_XN = 32u << 20;
constexpr size_t EO_KP = (size_t)16896 * 1024, EO_VP = EO_KP + (size_t)16384 * 512, EO_KS = EO_VP + (size_t)16384 * 512, EO_VS = EO_KS + (size_t)512 * 512;
constexpr int XM_PROMPT = 16384;
constexpr float QSCALE = 0.125f * 1.4426950408889634f;

struct EpiIn {
    static constexpr bool PERM = true, AFTER_DRAIN = false;
    unsigned char* ws; float* out; const float *gq, *gk;
    __device__ __forceinline__ void operator()(const f32x4 (&acc)[2][2][4][2], const Unit& u, int wr, int wc, int fr, int fq) const {
        const int row0 = u.pm * BM + wr * 64 + fr; const int pn = u.pn;
        if (pn < 4) {
            bf16_t* dst = (bf16_t*)(ws + ((pn < 2) ? EW_U : EW_GV)); float* st1 = (float*)ws + EC_ST1; float* st2 = (float*)ws + EC_ST2; const int col0 = (pn & 1) * 256 + wc * 32 + 8 * fq; const bool stats = pn >= 2;
#pragma unroll
            for (int ai = 0; ai < 2; ++ai)
#pragma unroll
                for (int m = 0; m < 4; ++m) { const int row = row0 + ai * HALF + m * 16; bf16_t* rowp = dst + (size_t)row * 512 + col0; float s1 = 0.f, s2 = 0.f;
#pragma unroll
                    for (int bj = 0; bj < 2; ++bj) { f32x4 v0 = acc[ai][bj][m][0], v1 = acc[ai][bj][m][1];
#pragma unroll
                        for (int j = 0; j < 4; ++j) { v0[j] = gelu_t(v0[j]); v1[j] = gelu_t(v1[j]); }
                        s1 += (v0[0] + v0[1]) + (v0[2] + v0[3]) + (v1[0] + v1[1]) + (v1[2] + v1[3]);
                        s2 += (v0[0] * v0[0] + v0[1] * v0[1]) + (v0[2] * v0[2] + v0[3] * v0[3]) + (v1[0] * v1[0] + v1[1] * v1[1]) + (v1[2] * v1[2] + v1[3] * v1[3]);
                        u32x4 w; w.x = cvt_pk_bf16(v0[0], v0[1]); w.y = cvt_pk_bf16(v0[2], v0[3]); w.z = cvt_pk_bf16(v1[0], v1[1]); w.w = cvt_pk_bf16(v1[2], v1[3]);
                        *(u32x4*)(rowp + bj * HALF) = w; }
                    if (stats) { s1 = quad_sum(s1); s2 = quad_sum(s2); if (fq == 0) { atomicAdd(st1 + row, s1); atomicAdd(st2 + row, s2); } } }
        } else {
            const int sec = pn >> 1, head = 4 * (pn & 1) + wc; const bool prompt = u.pm < (XM_PROMPT / BM);
            bf16_t* dst = (bf16_t*)(ws + ((sec == 2) ? EW_Q : (sec == 3) ? EW_K : EW_V)); const float* gp = (sec == 2) ? gq : gk;
            float* fo = (sec == 2) ? nullptr : out + ((sec == 3) ? (prompt ? EO_KP : EO_KS) : (prompt ? EO_VP : EO_VS));
            f32x4 gv[2][2];
#pragma unroll
            for (int bj = 0; bj < 2; ++bj)
#pragma unroll
                for (int n = 0; n < 2; ++n) gv[bj][n] = (sec < 4) ? *(const f32x4*)(gp + 32 * bj + 8 * fq + 4 * n) : (f32x4){1.f, 1.f, 1.f, 1.f};
            const float post = (sec == 2) ? QSCALE : 1.0f;
#pragma unroll
            for (int ai = 0; ai < 2; ++ai)
#pragma unroll
                for (int m = 0; m < 4; ++m) { const int row = row0 + ai * HALF + m * 16; const int orow = prompt ? row : row - XM_PROMPT;
                    float ss = 0.f;
#pragma unroll
                    for (int bj = 0; bj < 2; ++bj)
#pragma unroll
                        for (int n = 0; n < 2; ++n) { const f32x4 x = acc[ai][bj][m][n]; ss += (x[0] * x[0] + x[1] * x[1]) + (x[2] * x[2] + x[3] * x[3]); }
                    ss = quad_sum(ss);
                    const float rr = (sec < 4) ? post * (1.0f / sqrtf(ss * (1.0f / 64.0f) + 1e-6f)) : 1.0f;
#pragma unroll
                    for (int bj = 0; bj < 2; ++bj) { const f32x4 v0 = acc[ai][bj][m][0] * rr * gv[bj][0], v1 = acc[ai][bj][m][1] * rr * gv[bj][1];
                        const int dcol = 64 * head + 32 * bj + 8 * fq;
                        u32x4 w; w.x = cvt_pk_bf16(v0[0], v0[1]); w.y = cvt_pk_bf16(v0[2], v0[3]); w.z = cvt_pk_bf16(v1[0], v1[1]); w.w = cvt_pk_bf16(v1[2], v1[3]);
                        *(u32x4*)(dst + (size_t)row * 512 + dcol) = w;
                        if (fo) { float* op = fo + (size_t)orow * 512 + dcol; if (prompt) { __builtin_nontemporal_store(v0, (f32x4*)op); __builtin_nontemporal_store(v1, (f32x4*)(op + 4)); } else { *(f32x4*)op = v0; *(f32x4*)(op + 4) = v1; } } } }
        }
    }
};
struct EpiWo {
    static constexpr bool PERM = true, AFTER_DRAIN = false;
    const float *ga; unsigned char* ws;
    __device__ __forceinline__ void operator()(const f32x4 (&acc)[2][2][4][2], const Unit& u, int wr, int wc, int fr, int fq) const {
        const int row0 = u.pm * BM + wr * 64 + fr; const int col0 = u.pn * BM + wc * 32 + 8 * fq;
        const char* xn = (const char*)(ws + EW_XN); const float* rs = (const float*)ws + EC_RS; bf16_t* x1b = (bf16_t*)(ws + EW_X1B); float* ss = (float*)ws + EC_SS;
        f32x4 gi[2][2];
#pragma unroll
        for (int bj = 0; bj < 2; ++bj)
#pragma unroll
            for (int n = 0; n < 2; ++n) { const f32x4 g = *(const f32x4*)(ga + col0 + bj * HALF + 4 * n); gi[bj][n] = (f32x4){1.0f / g[0], 1.0f / g[1], 1.0f / g[2], 1.0f / g[3]}; }
#pragma unroll
        for (int ai = 0; ai < 2; ++ai)
#pragma unroll
            for (int m = 0; m < 4; ++m) { const int row = row0 + ai * HALF + m * 16; float s = 0.f; const float rinv = 1.0f / rs[row];
#pragma unroll
                for (int bj = 0; bj < 2; ++bj) { const u32x4 xw = *(const u32x4*)(xn + img_off(row, col0 + bj * HALF, 16));
                    const f32x4 x0 = (f32x4){__builtin_bit_cast(float, xw.x << 16), __builtin_bit_cast(float, xw.x & 0xffff0000u), __builtin_bit_cast(float, xw.y << 16), __builtin_bit_cast(float, xw.y & 0xffff0000u)} * rinv * gi[bj][0];
                    const f32x4 x1 = (f32x4){__builtin_bit_cast(float, xw.z << 16), __builtin_bit_cast(float, xw.z & 0xffff0000u), __builtin_bit_cast(float, xw.w << 16), __builtin_bit_cast(float, xw.w & 0xffff0000u)} * rinv * gi[bj][1];
                    const f32x4 v0 = acc[ai][bj][m][0] + x0, v1 = acc[ai][bj][m][1] + x1;
                    s += (v0[0] * v0[0] + v0[1] * v0[1]) + (v0[2] * v0[2] + v0[3] * v0[3]) + (v1[0] * v1[0] + v1[1] * v1[1]) + (v1[2] * v1[2] + v1[3] * v1[3]);
                    u32x4 w; w.x = cvt_pk_bf16(v0[0], v0[1]); w.y = cvt_pk_bf16(v0[2], v0[3]); w.z = cvt_pk_bf16(v1[0], v1[1]); w.w = cvt_pk_bf16(v1[2], v1[3]);
                    *(u32x4*)((char*)x1b + img_off(row, col0 + bj * HALF, 16)) = w; }
                s = quad_sum(s); if (fq == 0) atomicAdd(ss + row, s); }
    }
};
struct EpiGU {
    static constexpr bool PERM = true, AFTER_DRAIN = false;
    unsigned char* ws;
    __device__ __forceinline__ void operator()(const f32x4 (&acc)[2][2][4][2], const Unit& u, int wr, int wc, int fr, int fq) const {
        const int row0 = u.pm * BM + wr * 64 + fr; const int col0 = u.pn * HALF + wc * 32 + 8 * fq; const float* ss = (const float*)ws + EC_SS; bf16_t* H = (bf16_t*)(ws + EW_H);
#pragma unroll
        for (int ai = 0; ai < 2; ++ai)
#pragma unroll
            for (int m = 0; m < 4; ++m) { const int row = row0 + ai * HALF + m * 16;
                const float r = 1.0f / sqrtf(__hip_atomic_load(ss + row, __ATOMIC_RELAXED, __HIP_MEMORY_SCOPE_AGENT) * (1.0f / 1024.0f) + 1e-6f);
                float a[8];
#pragma unroll
                for (int n = 0; n < 2; ++n)
#pragma unroll
                    for (int j = 0; j < 4; ++j) a[4 * n + j] = silu_f(acc[ai][0][m][n][j] * r) * (acc[ai][1][m][n][j] * r);
                u32x4 w; w.x = cvt_pk_bf16(a[0], a[1]); w.y = cvt_pk_bf16(a[2], a[3]); w.z = cvt_pk_bf16(a[4], a[5]); w.w = cvt_pk_bf16(a[6], a[7]);
                *(u32x4*)((char*)H + img_off(row, col0, 44)) = w; }
    }
};
struct EpiDown {
    static constexpr bool PERM = true, AFTER_DRAIN = false;
    float* y; const unsigned char* ws;
    __device__ __forceinline__ void operator()(const f32x4 (&acc)[2][2][4][2], const Unit& u, int wr, int wc, int fr, int fq) const {
        const int row0 = u.pm * BM + wr * 64 + fr; const int col0 = u.pn * BM + wc * 32 + 8 * fq; const char* x1b = (const char*)(ws + EW_X1B);
#pragma unroll
        for (int ai = 0; ai < 2; ++ai)
#pragma unroll
            for (int m = 0; m < 4; ++m) { const int row = row0 + ai * HALF + m * 16; const size_t off = (size_t)row * 1024 + col0;
#pragma unroll
                for (int bj = 0; bj < 2; ++bj) { const u32x4 xb = __builtin_nontemporal_load((const u32x4*)(x1b + img_off(row, col0 + bj * HALF, 16))); float* p = y + off + bj * HALF;
                    const f32x4 x0 = (f32x4){__builtin_bit_cast(float, xb.x << 16), __builtin_bit_cast(float, xb.x & 0xffff0000u), __builtin_bit_cast(float, xb.y << 16), __builtin_bit_cast(float, xb.y & 0xffff0000u)};
                    const f32x4 x1 = (f32x4){__builtin_bit_cast(float, xb.z << 16), __builtin_bit_cast(float, xb.z & 0xffff0000u), __builtin_bit_cast(float, xb.w << 16), __builtin_bit_cast(float, xb.w & 0xffff0000u)};
                    __builtin_nontemporal_store(acc[ai][bj][m][0] + x0, (f32x4*)p); __builtin_nontemporal_store(acc[ai][bj][m][1] + x1, (f32x4*)(p + 4)); } }
    }
};

template <class Epi, class Sched, bool ALIGN_EPI = false, bool SP2 = false>
__device__ __forceinline__ void gemm_phase(PG8_LAS unsigned char* lds, const Gemm g, const Sched& S, const Epi& E) {
    const int tid = threadIdx.x, wid = __builtin_amdgcn_readfirstlane(tid >> 6), lane = tid & 63, wr = wid >> 2, wc = wid & 3, fr = lane & 15, fq = lane >> 4;
    const int K = g.K, nt = K / BK;
    unsigned voffA[2], voffB[2];
#pragma unroll
    for (int i = 0; i < 2; ++i) { voffA[i] = (unsigned)(tid * 16 + i * 8192); voffB[i] = voffA[i]; }
    static_assert(Epi::PERM, "image layout: B images are written with the perm32 row order");
    const size_t kstep = (size_t)HTB;
    const size_t hstep = (size_t)HALF * K * 2;
    const size_t tstep = 2 * hstep;
    const unsigned ldsw = (unsigned)wid * 1024u;
    const int aoff = lds_byte(wr * 64 + fr, fq * 8), boff = lds_byte(wc * 32 + fr, fq * 8);
#define PG8_SA(b, h) (((b) * 2 + (h)) * HTB)
#define PG8_SB(b, h) ((4 + (b) * 2 + (h)) * HTB)
#define PG8_STAGE(bufoff, gbase, voff) do { _Pragma("unroll") for (int _i = 0; _i < 2; ++_i) \
        __builtin_amdgcn_global_load_lds((const unsigned*)((const char*)(gbase) + (voff)[_i]), (PG8_LAS unsigned*)(lds + (bufoff) + ldsw + _i * 8192), 16, 0, 0); } while (0)
#define PG8_LDA(dst, b, h) do { _Pragma("unroll") for (int m = 0; m < 4; ++m) _Pragma("unroll") for (int k = 0; k < 2; ++k) dst[m][k] = *(const PG8_LAS bf16x8*)(lds + PG8_SA(b, h) + aoff + m * 2048 + k * 1024); } while (0)
#define PG8_LDB(dst, b, h) do { _Pragma("unroll") for (int n = 0; n < 2; ++n) _Pragma("unroll") for (int k = 0; k < 2; ++k) dst[n][k] = *(const PG8_LAS bf16x8*)(lds + PG8_SB(b, h) + boff + n * 2048 + k * 1024); } while (0)
#define PG8_MMA(ai, bj, At, Bt) do { __builtin_amdgcn_s_setprio(1); _Pragma("unroll") for (int m = 0; m < 4; ++m) _Pragma("unroll") for (int n = 0; n < 2; ++n) _Pragma("unroll") for (int k = 0; k < 2; ++k) \
        acc[ai][bj][m][n] = __builtin_amdgcn_mfma_f32_16x16x32_bf16(Bt[n][k], At[m][k], acc[ai][bj][m][n], 0, 0, 0); __builtin_amdgcn_s_setprio(0); } while (0)
#define PG8_WAIT_V(n) asm volatile("s_waitcnt vmcnt(" #n ")" ::: "memory")
#define PG8_WAIT_L(n) asm volatile("s_waitcnt lgkmcnt(" #n ")" ::: "memory")
#define PG8_BAR __builtin_amdgcn_s_barrier()
#define PG8_SCHED __builtin_amdgcn_sched_barrier(0)
    Unit cur, nxt; int ui = 0;
    if (!S.next(0, cur)) return;
    f32x4 acc[2][2][4][2];
#pragma unroll
    for (int a = 0; a < 2; ++a)
#pragma unroll
        for (int b = 0; b < 2; ++b)
#pragma unroll
            for (int m = 0; m < 4; ++m)
#pragma unroll
                for (int n = 0; n < 2; ++n) acc[a][b][m][n] = (f32x4){0.f, 0.f, 0.f, 0.f};
    bf16x8 At[4][2], B0[2][2], B1[2][2];
    const char* cA = (const char*)g.A + (size_t)cur.pm * tstep; const char* cB = (const char*)g.Bt + (size_t)cur.pn * tstep;
    S.a_ready(cur);
    if constexpr (SP2) {
        PG8_STAGE(PG8_SB(0, 0), cB, voffB); PG8_STAGE(PG8_SB(0, 1), cB + hstep, voffB); PG8_STAGE(PG8_SA(0, 0), cA, voffA); PG8_STAGE(PG8_SA(0, 1), cA + hstep, voffA);
        if (wr == 1) PG8_BAR;
        PG8_WAIT_V(2); PG8_BAR;
        PG8_STAGE(PG8_SB(1, 0), cB + kstep, voffB); PG8_STAGE(PG8_SA(1, 0), cA + kstep, voffA); PG8_STAGE(PG8_SB(1, 1), cB + hstep + kstep, voffB);
        PG8_WAIT_V(6); PG8_BAR;
    } else {
        PG8_STAGE(PG8_SB(0, 0), cB, voffB); PG8_STAGE(PG8_SA(0, 0), cA, voffA); PG8_STAGE(PG8_SB(0, 1), cB + hstep, voffB); PG8_STAGE(PG8_SA(0, 1), cA + hstep, voffA);
        if (wr == 1) PG8_BAR;
        PG8_WAIT_V(4); PG8_BAR;
        PG8_STAGE(PG8_SB(1, 0), cB + kstep, voffB); PG8_STAGE(PG8_SA(1, 0), cA + kstep, voffA); PG8_STAGE(PG8_SB(1, 1), cB + hstep + kstep, voffB);
        PG8_WAIT_V(6); PG8_BAR;
    }
    for (;;) {
        const bool has_next = S.next(ui + 1, nxt);
        const char* nA = has_next ? (const char*)g.A + (size_t)nxt.pm * tstep : cA; const char* nB = has_next ? (const char*)g.Bt + (size_t)nxt.pn * tstep : cB;
        for (int t = 0; t < nt; t += 2) {
            const bool last = (t == nt - 2);
            const char* a1 = cA + (size_t)(t + 1) * kstep;
            const char* a2 = last ? nA : cA + (size_t)(t + 2) * kstep; const char* b2 = last ? nB : cB + (size_t)(t + 2) * kstep;
            const char* a3 = a2 + kstep; const char* b3 = b2 + kstep;
            if (last && has_next) S.a_ready(nxt);
            if constexpr (SP2) {
            PG8_LDB(B0, 0, 0); PG8_LDB(B1, 0, 1); PG8_SCHED; PG8_LDA(At, 0, 0); PG8_STAGE(PG8_SA(1, 1), a1 + hstep, voffA);
            PG8_WAIT_V(8); PG8_WAIT_L(0); PG8_BAR; PG8_MMA(0, 0, At, B0); PG8_MMA(0, 1, At, B1); PG8_BAR; PG8_SCHED;
            PG8_LDA(At, 0, 1); PG8_STAGE(PG8_SB(0, 0), b2, voffB); PG8_STAGE(PG8_SB(0, 1), b2 + hstep, voffB); PG8_STAGE(PG8_SA(0, 0), a2, voffA);
            PG8_WAIT_V(8); PG8_WAIT_L(0); PG8_BAR; PG8_MMA(1, 0, At, B0); PG8_MMA(1, 1, At, B1); PG8_BAR; PG8_SCHED;
            PG8_LDB(B0, 1, 0); PG8_LDB(B1, 1, 1); PG8_SCHED; PG8_LDA(At, 1, 0); PG8_STAGE(PG8_SA(0, 1), a2 + hstep, voffA);
            PG8_WAIT_V(8); PG8_WAIT_L(0); PG8_BAR; PG8_MMA(0, 0, At, B0); PG8_MMA(0, 1, At, B1); PG8_BAR; PG8_SCHED;
            PG8_LDA(At, 1, 1); PG8_STAGE(PG8_SB(1, 0), b3, voffB); PG8_STAGE(PG8_SB(1, 1), b3 + hstep, voffB); PG8_STAGE(PG8_SA(1, 0), a3, voffA);
            PG8_WAIT_V(8); PG8_WAIT_L(0); PG8_BAR; PG8_MMA(1, 0, At, B0); PG8_MMA(1, 1, At, B1); PG8_BAR; PG8_SCHED;
            } else {
            PG8_LDB(B0, 0, 0); PG8_SCHED; PG8_LDA(At, 0, 0); PG8_STAGE(PG8_SA(1, 1), a1 + hstep, voffA);
            PG8_WAIT_L(8); PG8_BAR; PG8_WAIT_L(0); PG8_MMA(0, 0, At, B0); PG8_BAR; PG8_SCHED;
            PG8_LDB(B1, 0, 1); PG8_STAGE(PG8_SB(0, 0), b2, voffB);
            PG8_BAR; PG8_WAIT_L(0); PG8_MMA(0, 1, At, B1); PG8_BAR;
            PG8_LDA(At, 0, 1); PG8_STAGE(PG8_SA(0, 0), a2, voffA);
            PG8_BAR; PG8_WAIT_L(0); PG8_MMA(1, 0, At, B0); PG8_BAR; PG8_SCHED;
            PG8_STAGE(PG8_SB(0, 1), b2 + hstep, voffB);
            PG8_WAIT_V(6); PG8_BAR; PG8_MMA(1, 1, At, B1); PG8_BAR;
            PG8_LDB(B0, 1, 0); PG8_SCHED; PG8_LDA(At, 1, 0); PG8_STAGE(PG8_SA(0, 1), a2 + hstep, voffA);
            PG8_WAIT_L(8); PG8_BAR; PG8_WAIT_L(0); PG8_MMA(0, 0, At, B0); PG8_BAR; PG8_SCHED;
            PG8_LDB(B1, 1, 1); PG8_STAGE(PG8_SB(1, 0), b3, voffB);
            PG8_BAR; PG8_WAIT_L(0); PG8_MMA(0, 1, At, B1); PG8_BAR;
            PG8_LDA(At, 1, 1); PG8_STAGE(PG8_SA(1, 0), a3, voffA);
            PG8_BAR; PG8_WAIT_L(0); PG8_MMA(1, 0, At, B0); PG8_BAR; PG8_SCHED;
            PG8_STAGE(PG8_SB(1, 1), b3 + hstep, voffB);
            PG8_WAIT_V(6); PG8_BAR; PG8_MMA(1, 1, At, B1); PG8_BAR;
            }
        }
        if constexpr (ALIGN_EPI) { if (wr == 0) PG8_BAR; }
        if constexpr (!Epi::AFTER_DRAIN) { E(acc, cur, wr, wc, fr, fq); S.done(cur); }
        if (!has_next) break;
#pragma unroll
        for (int a = 0; a < 2; ++a)
#pragma unroll
            for (int b = 0; b < 2; ++b)
#pragma unroll
                for (int m = 0; m < 4; ++m)
#pragma unroll
                    for (int n = 0; n < 2; ++n) acc[a][b][m][n] = (f32x4){0.f, 0.f, 0.f, 0.f};
        cur = nxt; cA = nA; cB = nB; ++ui;
        if constexpr (ALIGN_EPI) { if (wr == 1) PG8_BAR; }
    }
    PG8_WAIT_V(0);
    if constexpr (!ALIGN_EPI) { if (wr == 0) PG8_BAR; }
    PG8_BAR;
    if constexpr (Epi::AFTER_DRAIN) { E.fused(acc, cur, wr, wc, fr, fq, lds, wid, lane); S.done(cur); }
#undef PG8_SA
#undef PG8_SB
#undef PG8_STAGE
#undef PG8_LDA
#undef PG8_LDB
#undef PG8_MMA
#undef PG8_WAIT_V
#undef PG8_WAIT_L
#undef PG8_BAR
#undef PG8_SCHED
}
}
#ifndef PG8_SP2
#define PG8_SP2 true
#endif
#ifndef PG8_ALIGN
#define PG8_ALIGN true
#endif
#ifndef MK_N_LAUNCHES
#define MK_N_LAUNCHES 1
#endif
constexpr int NWAVES = 8;
constexpr int N_LAUNCHES = MK_N_LAUNCHES;
constexpr int PER_PHASE = 6;

constexpr int DM = 1024, SEQ = 2048, NBATCH = 8, MP = NBATCH * SEQ, NDEC = 128, TDEC = 4, MS = NDEC * TDEC, M = MP + MS;
constexpr int WA = 512, NIN = 2560, DFF = 2816, NGU = 2 * DFF, LB = 2048;
constexpr float EPS = 1e-6f;
constexpr size_t O_Y = 0, O_KP = (size_t)M * DM, O_VP = O_KP + (size_t)MP * 512, O_KS = O_VP + (size_t)MP * 512, O_VS = O_KS + (size_t)MS * 512, O_VC = O_VS + (size_t)MS * 512, O_END = O_VC + (size_t)MS * 512;
constexpr size_t MiB = 1u << 20;
constexpr size_t WS_CTL = 0, CTL_ZERO_BYTES = 1 * MiB;
constexpr size_t WS_WIN = 2 * MiB, WS_WO = 8 * MiB, WS_WGU = 10 * MiB, WS_WD = 22 * MiB, WS_WS = 28 * MiB;
constexpr size_t WS_XN = 32 * MiB, WS_U = 66 * MiB, WS_GV = 83 * MiB, WS_Q = 100 * MiB, WS_K = 117 * MiB, WS_V = 134 * MiB, WS_MIX = 152 * MiB, WS_X1B = 186 * MiB, WS_H = 220 * MiB, WS_END = 312 * MiB;
static_assert(WS_WIN + (size_t)NIN * DM * 2 <= WS_WO && WS_WGU + (size_t)NGU * DM * 2 <= WS_WD && WS_WD + (size_t)DM * DFF * 2 <= WS_WS && WS_XN + (size_t)M * DM * 2 <= WS_U && WS_U + (size_t)M * 512 * 2 <= WS_GV &&
              WS_MIX + (size_t)M * DM * 2 <= WS_X1B && WS_X1B + (size_t)M * DM * 2 <= WS_H && WS_H + (size_t)M * DFF * 2 <= WS_END, "d_ws map");
constexpr int CW_TMO = 0, CW_CODE = 1, CW_QUEUE = 64, CW_BAR = 4096, CW_ST1 = 16384, CW_ST2 = CW_ST1 + M, CW_SS = CW_ST2 + M, CW_RS = CW_SS + M, CW_END = CW_RS + M;
static_assert(CW_END * 4 <= (int)CTL_ZERO_BYTES, "CTL words inside the memset region");
static_assert(pg8::EW_U == WS_U && pg8::EW_GV == WS_GV && pg8::EW_Q == WS_Q && pg8::EW_K == WS_K && pg8::EW_V == WS_V && pg8::EW_X1B == WS_X1B && pg8::EW_H == WS_H && pg8::EC_ST1 == CW_ST1 && pg8::EC_ST2 == CW_ST2 && pg8::EC_SS == CW_SS && pg8::EC_RS == CW_RS && pg8::EW_XN == WS_XN && pg8::EO_KP == O_KP && pg8::EO_VP == O_VP && pg8::EO_KS == O_KS && pg8::EO_VS == O_VS && WS_CTL == 0, "epilogue constants match the maps");
constexpr int RING_OFF = 0, RING_BYTES = 131072;
constexpr int LDSCTL_OFF = RING_BYTES, MISC_OFF = LDSCTL_OFF + 320, RED_OFF = RING_BYTES + 1024;
constexpr int LDS_BYTES = 147456;
static_assert(RED_OFF + 4096 + 8192 <= LDS_BYTES, "LDS map");

#define GAS __attribute__((address_space(1)))
#define LAS __attribute__((address_space(3)))
typedef unsigned short bf16;
typedef unsigned v4u __attribute__((ext_vector_type(4)));
typedef unsigned v2u __attribute__((ext_vector_type(2)));
typedef float f32x4 __attribute__((ext_vector_type(4)));
typedef float f32x16 __attribute__((ext_vector_type(16)));
typedef short bf16x8 __attribute__((ext_vector_type(8)));
typedef short v4i16_t __attribute__((ext_vector_type(4)));
typedef GAS unsigned gu32;
#define RLX_AGENT __ATOMIC_RELAXED, __HIP_MEMORY_SCOPE_AGENT
#define LDS_WAIT() asm volatile("s_waitcnt lgkmcnt(0)" ::: "memory")
#define VM_WAIT() asm volatile("s_waitcnt vmcnt(0)" ::: "memory")
__device__ __forceinline__ unsigned f2bf(float f) { unsigned u = __builtin_bit_cast(unsigned, f); return (u + 0x7fffu + ((u >> 16) & 1u)) >> 16; }
__device__ __forceinline__ unsigned pk2(float lo, float hi) { return pg8::cvt_pk_bf16(lo, hi); }
__device__ __forceinline__ float bf_lo(unsigned w) { return __builtin_bit_cast(float, w << 16); }
__device__ __forceinline__ float bf_hi(unsigned w) { return __builtin_bit_cast(float, w & 0xffff0000u); }
__device__ __forceinline__ float bf2f(bf16 b) { return __builtin_bit_cast(float, (unsigned)b << 16); }

#define XB_TMO      128
#define XB_XCNT(j)  (256  + 64 * (j))
#define XB_XSUB(j)  (1280 + 64 * (j))
#define XB_XGEN(j)  (2304 + 64 * (j))
#define XB_TOP      3328
#define XB_TOPGEN   3392
#define XCD_BAR_WORDS 3456
#define XB_SPIN_CAP (1u << 18)

__device__ __forceinline__ unsigned xb_ld(unsigned* p)              { return __hip_atomic_load(p, __ATOMIC_RELAXED, __HIP_MEMORY_SCOPE_AGENT); }
__device__ __forceinline__ unsigned xb_add(unsigned* p, unsigned v) { return __hip_atomic_fetch_add(p, v, __ATOMIC_RELAXED, __HIP_MEMORY_SCOPE_AGENT); }
__device__ __forceinline__ unsigned xb_xcc_id() { return (unsigned)__builtin_amdgcn_s_getreg((3 << 11) | 20) & 0xFu; }
#define XB_SPIN(cond, bar) do { unsigned _sp = 0; while (cond) { __builtin_amdgcn_s_sleep(1); \
    if ((++_sp & 255u) == 0u) { if (xb_ld(&(bar)[XB_TMO])) break; if (_sp > XB_SPIN_CAP) { atomicAdd(&(bar)[XB_TMO], 1u); break; } } } } while (0)

struct XcdBarrier {
    unsigned* bar; unsigned x;
    volatile LAS unsigned* st;
};

__device__ __forceinline__ XcdBarrier xcd_barrier_post(unsigned* bar, volatile LAS unsigned* st) {
    XcdBarrier b; b.bar = bar; b.x = xb_xcc_id(); b.st = st;
    if (threadIdx.x == 0) (void)xb_add(&bar[XB_XCNT(b.x)], 1u);
    return b;
}
__device__ __forceinline__ void xcd_barrier_complete(unsigned* bar, unsigned x, unsigned& nloc, unsigned& nx) {
    const unsigned G = gridDim.x * gridDim.y * gridDim.z;
    unsigned sum, cnt, mine, sp = 0u;
    for (;;) {
        sum = 0u; cnt = 0u; mine = 0u;
#pragma unroll
        for (unsigned j = 0; j < 16; ++j) { const unsigned c = xb_ld(&bar[XB_XCNT(j)]); sum += c; cnt += (c > 0u) ? 1u : 0u; mine = (j == x) ? c : mine; }
        if (sum == G) break;
        __builtin_amdgcn_s_sleep(1);
        if ((++sp & 255u) == 0u) { if (xb_ld(&bar[XB_TMO])) break; if (sp > XB_SPIN_CAP) { atomicAdd(&bar[XB_TMO], 1u); break; } }
    }
    nloc = mine > 0u ? mine : 1u; nx = cnt > 0u ? cnt : 1u;
}

__device__ __forceinline__ void xcd_barrier(const XcdBarrier& b) {
    asm volatile("s_waitcnt vmcnt(0)" ::: "memory");
    __syncthreads();
    if (threadIdx.x == 0) {
        unsigned* bar = b.bar;
        __builtin_amdgcn_s_waitcnt(0);
        unsigned nloc = b.st[0], nx = b.st[1];
        if (nloc == 0u) { xcd_barrier_complete(bar, b.x, nloc, nx); b.st[0] = nloc; b.st[1] = nx; }
        const unsigned old = xb_add(&bar[XB_XSUB(b.x)], 1u);
        const unsigned gen = old / nloc;
        if (old + 1u == (gen + 1u) * nloc) {
            __builtin_amdgcn_fence(__ATOMIC_RELEASE, "agent");
            asm volatile("s_waitcnt vmcnt(0)" ::: "memory");
            const unsigned og = xb_add(&bar[XB_TOP], 1u);
            const unsigned tg = og / nx;
            if (og + 1u == (tg + 1u) * nx) xb_add(&bar[XB_TOPGEN], 1u);
            else XB_SPIN(xb_ld(&bar[XB_TOPGEN]) == tg, bar);
            __builtin_amdgcn_fence(__ATOMIC_ACQUIRE, "agent");
            xb_add(&bar[XB_XGEN(b.x)], 1u);
            asm volatile("s_waitcnt vmcnt(0)" ::: "memory");
        } else {
            XB_SPIN(xb_ld(&bar[XB_XGEN(b.x)]) == gen, bar);
            __builtin_amdgcn_fence(__ATOMIC_ACQUIRE, "agent");
            asm volatile("s_waitcnt vmcnt(0)" ::: "memory");
        }
    }
    __syncthreads();
}
struct Args { const float* in[19]; float* out; unsigned char* ws; int ph_lo, ph_hi; };
struct Frame {
    LAS unsigned char* lds;
    volatile LAS unsigned* MISC;
    gu32* ctl;
    int tid, lane, wave;
    int vcu, G;
    unsigned char* ws; float* out;
};

__device__ __forceinline__ float wave_sum(float v) {
#pragma unroll
    for (int o = 1; o < 64; o <<= 1) v += __shfl_xor(v, o);
    return v;
}
__device__ __forceinline__ float wave_max(float v) {
#pragma unroll
    for (int o = 1; o < 64; o <<= 1) v = fmaxf(v, __shfl_xor(v, o));
    return v;
}
__device__ __forceinline__ int win_drow(int n0) { const int sec = n0 >> 9; if (sec < 2) return n0; const int cs = n0 & 511, head = cs >> 6, dh = (cs >> 5) & 1; return 256 * (2 * sec + (head >> 2)) + 128 * dh + 32 * (head & 3); }
struct RPair { f32x4 v0[4], v1[4]; };
__device__ __forceinline__ const float* x_row(const Args& A, int m) { return (m < MP) ? A.in[0] + (size_t)m * DM : A.in[1] + (size_t)(m - MP) * DM; }
__device__ __forceinline__ void rms_pair_load(RPair& P, const Args& A, int m, int lane) {
    if (m >= M) return;
    const GAS f32x4* xr0 = (const GAS f32x4*)x_row(A, m) + lane; const GAS f32x4* xr1 = (const GAS f32x4*)x_row(A, m + 1) + lane;
#pragma unroll
    for (int j = 0; j < 4; ++j) { P.v0[j] = __builtin_nontemporal_load(xr0 + 64 * j); P.v1[j] = __builtin_nontemporal_load(xr1 + 64 * j); }
}
__device__ __forceinline__ void rms_pair_finish(const RPair& P, const float* g, bf16* obase, float* rs, int m, int lane) {
    if (m >= M) return;
    const GAS f32x4* gr = (const GAS f32x4*)g + lane; float s0 = 0.f, s1 = 0.f;
#pragma unroll
    for (int j = 0; j < 4; ++j) { s0 += (P.v0[j].x * P.v0[j].x + P.v0[j].y * P.v0[j].y) + (P.v0[j].z * P.v0[j].z + P.v0[j].w * P.v0[j].w); s1 += (P.v1[j].x * P.v1[j].x + P.v1[j].y * P.v1[j].y) + (P.v1[j].z * P.v1[j].z + P.v1[j].w * P.v1[j].w); }
    const float r0 = 1.f / sqrtf(wave_sum(s0) * (1.f / DM) + EPS), r1 = 1.f / sqrtf(wave_sum(s1) * (1.f / DM) + EPS);
    if (lane == 0) { rs[m] = r0; rs[m + 1] = r1; }
#pragma unroll
    for (int j = 0; j < 4; ++j) { const f32x4 gg = gr[64 * j]; v2u o;
        o.x = pk2(P.v0[j].x * r0 * gg.x, P.v0[j].y * r0 * gg.y); o.y = pk2(P.v0[j].z * r0 * gg.z, P.v0[j].w * r0 * gg.w); *(GAS v2u*)((GAS char*)obase + pg8::img_off(m, 4 * lane + 256 * j, DM / 64)) = o;
        o.x = pk2(P.v1[j].x * r1 * gg.x, P.v1[j].y * r1 * gg.y); o.y = pk2(P.v1[j].z * r1 * gg.z, P.v1[j].w * r1 * gg.w); *(GAS v2u*)((GAS char*)obase + pg8::img_off(m + 1, 4 * lane + 256 * j, DM / 64)) = o; }
}
constexpr int I_IN = (DM / 64) * (NIN / 32), I_O = (DM / 64) * (DM / 32), I_G = (DM / 64) * (DFF / 32), I_D = (DFF / 64) * (DM / 32), I_LATE = I_O + 2 * I_G + I_D, I_ALL = I_IN + I_LATE;
struct TItem { const float* W; const float* ks; bf16* WT; int N, Kt, drow0, k0, n0; bool ok; };
__device__ __forceinline__ TItem p0_item(const Args& A, unsigned char* ws, int u, int hi = I_ALL) {
    TItem t; t.ok = u < hi; t.ks = nullptr; t.W = A.in[5]; t.WT = (bf16*)(ws + WS_WIN); t.N = NIN; t.Kt = DM >> 6; t.drow0 = 0; t.k0 = 0; t.n0 = 0;
    if (!t.ok) return t;
    if (u < I_IN) { const int nblk = NIN / 32, kb = u / nblk, nb = u % nblk; t.k0 = 64 * kb; t.n0 = 32 * nb; t.drow0 = win_drow(32 * nb); return t; }
    int r = u - I_IN;
    if (r < I_O) { const int nblk = DM / 32, kb = r / nblk, nb = r % nblk; t.W = A.in[14]; t.WT = (bf16*)(ws + WS_WO); t.N = DM; t.k0 = 64 * kb; t.n0 = 32 * nb; t.drow0 = 32 * nb; return t; } r -= I_O;
    if (r < 2 * I_G) { const bool up = r >= I_G; if (up) r -= I_G; const int nblk = DFF / 32, kb = r / nblk, nb = r % nblk, n0 = 32 * nb;
        t.W = up ? A.in[17] : A.in[16]; t.ks = A.in[15]; t.WT = (bf16*)(ws + WS_WGU); t.N = DFF; t.k0 = 64 * kb; t.n0 = n0; t.drow0 = 256 * (n0 >> 7) + (up ? 128 : 0) + (n0 & 127); return t; } r -= 2 * I_G;
    { const int nblk = DM / 32, kb = r / nblk, nb = r % nblk; t.W = A.in[18]; t.WT = (bf16*)(ws + WS_WD); t.N = DM; t.Kt = DFF >> 6; t.k0 = 64 * kb; t.n0 = 32 * nb; t.drow0 = 32 * nb; }
    return t;
}
__device__ __forceinline__ void p0_t_load(const TItem& t, float (&w)[32], int lane) {
    if (!t.ok) return;
#pragma unroll
    for (int i = 0; i < 32; ++i) { const int kk = 2 * i + (lane >> 5); w[i] = __builtin_nontemporal_load(t.W + (size_t)(t.k0 + kk) * t.N + t.n0 + (lane & 31)); }
}
__device__ __forceinline__ void p0_t_finish(const TItem& t, const float (&w)[32], LAS float* scr, int lane) {
    if (!t.ok) return;
#pragma unroll
    for (int i = 0; i < 32; ++i) { const int kk = 2 * i + (lane >> 5); float v = w[i]; if (t.ks) v *= t.ks[t.k0 + kk]; scr[kk * 33 + (lane & 31)] = v; }
    LDS_WAIT(); asm volatile("" ::: "memory");
    const int c = lane & 7;
#pragma unroll
    for (int j = 0; j < 4; ++j) { const int n = (lane >> 3) + 8 * j; const LAS float* s = scr + (8 * c) * 33 + n;
        v4u o; o.x = pk2(s[0 * 33], s[1 * 33]); o.y = pk2(s[2 * 33], s[3 * 33]); o.z = pk2(s[4 * 33], s[5 * 33]); o.w = pk2(s[6 * 33], s[7 * 33]);
        *(GAS v4u*)((GAS char*)t.WT + pg8::img_off_b(t.drow0 + n, t.k0 + 8 * c, t.Kt)) = o; }
    LDS_WAIT(); asm volatile("" ::: "memory");
}
constexpr int I_EARLY = I_IN + I_O, I_GU_END = I_EARLY + 2 * I_G;
__device__ __forceinline__ void conv_range(Frame& F, const Args& A, int lo, int hi, int widx, int nw) {
    LAS float* scr = (LAS float*)(F.lds + RING_OFF + F.wave * 16384);
#pragma unroll 1
    for (int u0 = lo + widx; u0 < hi; u0 += 3 * nw) {
        int ln = F.lane; asm volatile("" : "+v"(ln));
        const TItem ta = p0_item(A, F.ws, u0, hi), tb = p0_item(A, F.ws, u0 + nw, hi), tc = p0_item(A, F.ws, u0 + 2 * nw, hi);
        float wa[32], wb[32], wc[32];
        p0_t_load(ta, wa, ln); p0_t_load(tb, wb, ln); p0_t_load(tc, wc, ln);
        p0_t_finish(ta, wa, scr, ln); p0_t_finish(tb, wb, scr, ln); p0_t_finish(tc, wc, scr, ln);
    }
}
__device__ __forceinline__ void conv_late(Frame& F, const Args& A, int nunits, int lo, int hi) {
    const int G = F.G, c = (int)blockIdx.x, rounds = (nunits + G - 1) / G, first_short = nunits - (rounds - 1) * G;
    const int nshort = G - first_short;
    if (nshort == 0) conv_range(F, A, lo, hi, c * NWAVES + F.wave, G * NWAVES);
    else if (c >= first_short) conv_range(F, A, lo, hi, (c - first_short) * NWAVES + F.wave, nshort * NWAVES);
}
__device__ __forceinline__ void p0_prologue(Frame& F, const Args& A) {
    LAS float* scr = (LAS float*)(F.lds + RING_OFF + F.wave * 16384);
    const int gw = F.vcu * NWAVES + F.wave, NGW = F.G * NWAVES;
#if PROBE_KIND == 4
    const unsigned long long q0 = __builtin_amdgcn_s_memrealtime();
#endif
    conv_range(F, A, 0, I_EARLY, gw, NGW);
#pragma unroll 1
    for (int m0 = 2 * gw; m0 < M; m0 += 10 * NGW) {
        int ln = F.lane; asm volatile("" : "+v"(ln));
        RPair pa, pb, pc, pd, pe; bf16* xn = (bf16*)(F.ws + WS_XN);
        rms_pair_load(pa, A, m0, ln); rms_pair_load(pb, A, m0 + 2 * NGW, ln); rms_pair_load(pc, A, m0 + 4 * NGW, ln); rms_pair_load(pd, A, m0 + 6 * NGW, ln); rms_pair_load(pe, A, m0 + 8 * NGW, ln);
        rms_pair_finish(pa, A.in[4], xn, (float*)F.ws + CW_RS, m0, ln); rms_pair_finish(pb, A.in[4], xn, (float*)F.ws + CW_RS, m0 + 2 * NGW, ln); rms_pair_finish(pc, A.in[4], xn, (float*)F.ws + CW_RS, m0 + 4 * NGW, ln); rms_pair_finish(pd, A.in[4], xn, (float*)F.ws + CW_RS, m0 + 6 * NGW, ln); rms_pair_finish(pe, A.in[4], xn, (float*)F.ws + CW_RS, m0 + 8 * NGW, ln);
    }
#if PROBE_KIND == 4
    asm volatile("s_waitcnt vmcnt(0)" ::: "memory"); const unsigned long long q1 = __builtin_amdgcn_s_memrealtime();
#endif
    for (int idx = gw; idx < 8 * 128; idx += NGW) { const int i = idx & 127;
#pragma unroll
        for (int q = 0; q < 2; ++q) { const int jj = F.lane + 64 * q; ((bf16*)(F.ws + WS_WS))[(size_t)idx * 128 + jj] = (jj <= i) ? (bf16)f2bf(A.in[8][(size_t)idx * 128 + jj]) : (bf16)0; } }
#if PROBE_KIND == 4
    asm volatile("s_waitcnt vmcnt(0)" ::: "memory"); const unsigned long long q2 = __builtin_amdgcn_s_memrealtime();
    if (blockIdx.x == 0 && F.wave == 0 && F.lane == 0) F.MISC[24] = (unsigned)(PROBE_SUB == 0 ? q1 - q0 : q2 - q1);
#endif
}
__device__ __forceinline__ float wgt(int delta, int qpos) {
    const int w = (delta <= 128 ? 1 : 0) + ((((delta & 3) == 0) && delta <= 512) ? 1 : 0) + ((((delta & 15) == 0) && delta <= 2048) ? 1 : 0);
    return ((unsigned)delta <= (unsigned)qpos) ? (float)w : 0.f;
}
__device__ __forceinline__ v4i16_t vtr(const LAS unsigned char* p) { return __builtin_amdgcn_ds_read_tr16_b64_v4i16((LAS v4i16_t*)p); }
__device__ __forceinline__ bf16x8 cat8(v4i16_t a, v4i16_t b) { return (bf16x8){a[0], a[1], a[2], a[3], b[0], b[1], b[2], b[3]}; }

struct KSet { bf16x8 kf[4]; };
__device__ __forceinline__ void a_tile_desc(int tt, int P0, int& kbase, int& stride) {
    if (tt < 6) { kbase = P0 - 2048 + 256 * tt; stride = 8; } else if (tt < 9) { kbase = P0 - 512 + 128 * (tt - 6); stride = 4; } else { kbase = P0 - 128 + 32 * (tt - 9); stride = 1; }
}
__device__ __forceinline__ void a_kstore(const v4u (&kv)[4], LAS unsigned char* slot, int lane) {
#pragma unroll
    for (int it = 0; it < 4; ++it) { const int row = (lane >> 3) + 8 * it; *(LAS v4u*)(slot + row * 128 + 16 * ((lane & 7) ^ ((row >> 1) & 7))) = kv[it]; }
}
__device__ __forceinline__ void a_kfrag(KSet& T, const LAS unsigned char* slot, int lane) {
    const int i = lane & 31, hi = lane >> 5, sw = (i >> 1) & 7;
#pragma unroll
    for (int kk = 0; kk < 4; ++kk) T.kf[kk] = *(const LAS bf16x8*)(slot + i * 128 + 16 * ((2 * kk + hi) ^ sw));
}
__device__ __forceinline__ void a_kvload(v4u (&kv)[4], v4u (&vv)[4], const bf16* Kh, const bf16* Vh, int tt, int P0, int lane) {
    int kbase, stride; a_tile_desc(tt > 20 ? 20 : tt, P0, kbase, stride);
    const int kp0 = kbase + stride * (lane >> 3), cb = 16 * (lane & 7);
#pragma unroll
    for (int it = 0; it < 4; ++it) { int kp = kp0 + 8 * stride * it; kp = kp < 0 ? 0 : (kp > SEQ - 1 ? SEQ - 1 : kp); const unsigned off = (unsigned)kp * 1024u + (unsigned)cb;
        kv[it] = *(const v4u*)((const char*)Kh + (size_t)off); vv[it] = *(const v4u*)((const char*)Vh + (size_t)off); }
}
__device__ __forceinline__ void a_vstore(const v4u (&vv)[4], LAS unsigned char* slot, int lane) {
#pragma unroll
    for (int it = 0; it < 4; ++it) *(LAS v4u*)(slot + ((lane >> 3) + 8 * it) * 128 + (lane & 7) * 16) = vv[it];
}
__device__ __forceinline__ f32x16 a_qk(const KSet& T, const bf16x8 (&qf)[4], float negb) {
    f32x16 s;
#pragma unroll
    for (int r = 0; r < 16; ++r) s[r] = negb;
#pragma unroll
    for (int kk = 0; kk < 4; ++kk) s = __builtin_amdgcn_mfma_f32_32x32x16_bf16(T.kf[kk], qf[kk], s, 0, 0, 0);
    return s;
}
template <int RANGE> __device__ __forceinline__ void a_periodic(float (&wp)[16], int P0, int qpos, int lane) {
    constexpr int ST = RANGE == 3 ? 8 : (RANGE == 2 ? 4 : 1);
    const int kb0 = RANGE == 3 ? P0 - 2048 : (RANGE == 2 ? P0 - 512 : P0 - 128);
    const int d0 = qpos - kb0 - ST * 4 * (lane >> 5);
#pragma unroll
    for (int r = 0; r < 16; ++r) { const int delta = d0 - ST * ((r & 3) + 8 * (r >> 2)); wp[r] = (RANGE == 1 ? (((delta & 3) == 0) ? 1.f : 0.f) : 0.f) + (((delta & 15) == 0) ? 1.f : 0.f); }
}
template <int RANGE>
__device__ __forceinline__ void a_softmax(f32x16 s, int tt, int P0, int qpos, int lane, const float (&wp)[16], bf16x8& pf0, bf16x8& pf1, float& lsum) {
    constexpr int ST = RANGE == 3 ? 8 : (RANGE == 2 ? 4 : 1);
    int kbase, stride; a_tile_desc(tt, P0, kbase, stride);
    const int hi = lane >> 5;
    const int d0 = qpos - kbase - ST * 4 * hi;
    const int lim3 = qpos < 2048 ? qpos : 2048;
    float ps = 0.f;
#pragma unroll
    for (int r = 0; r < 16; ++r) { const int delta = d0 - ST * ((r & 3) + 8 * (r >> 2)); float w;
        if (RANGE == 1) w = ((unsigned)delta <= (unsigned)qpos) ? wp[r] + (delta <= 128 ? 1.f : 0.f) : 0.f;
        else if (RANGE == 2) w = (delta <= qpos) ? wp[r] + (delta <= 512 ? 1.f : 0.f) : 0.f;
        else w = (delta <= lim3) ? wp[r] : 0.f;
        const float p = w * __builtin_amdgcn_exp2f(s[r]); ps += p; s[r] = p; }
    lsum += ps;
    v4u pa, pb; pa.x = pk2(s[0], s[1]); pa.y = pk2(s[2], s[3]); pa.z = pk2(s[4], s[5]); pa.w = pk2(s[6], s[7]); pb.x = pk2(s[8], s[9]); pb.y = pk2(s[10], s[11]); pb.z = pk2(s[12], s[13]); pb.w = pk2(s[14], s[15]);
    pf0 = __builtin_bit_cast(bf16x8, pa); pf1 = __builtin_bit_cast(bf16x8, pb);
}
__device__ __forceinline__ void a_pv(const bf16x8 pf0, const bf16x8 pf1, int lane, const LAS unsigned char* slot, f32x16& o0, f32x16& o1) {
    const int ii = lane & 15, hi = lane >> 5;
    const LAS unsigned char* vb = slot + (4 * hi + (ii >> 2)) * 128 + (16 * ((lane >> 4) & 1) + 4 * (ii & 3)) * 2;
    { const bf16x8 v00 = cat8(vtr(vb), vtr(vb + 1024)), v01 = cat8(vtr(vb + 2048), vtr(vb + 2048 + 1024));
      const bf16x8 v10 = cat8(vtr(vb + 64), vtr(vb + 64 + 1024)), v11 = cat8(vtr(vb + 64 + 2048), vtr(vb + 64 + 2048 + 1024));
      o0 = __builtin_amdgcn_mfma_f32_32x32x16_bf16(v00, pf0, o0, 0, 0, 0); o0 = __builtin_amdgcn_mfma_f32_32x32x16_bf16(v01, pf1, o0, 0, 0, 0);
      o1 = __builtin_amdgcn_mfma_f32_32x32x16_bf16(v10, pf0, o1, 0, 0, 0); o1 = __builtin_amdgcn_mfma_f32_32x32x16_bf16(v11, pf1, o1, 0, 0, 0); }
}
struct ASeq { int t, n1, n2, n3, ord, f2, f1; };
__device__ __forceinline__ int a_next(int tt, int f2, int f1) { int u = tt + 1; if (u == 6) u = 6 + f2; if (u == 9) u = 9 + f1; return u; }
__device__ __forceinline__ void a_step(ASeq& Q, v4u (&kv)[4], v4u (&vv)[4], f32x16& s_cur, int& wrange, float (&wp)[16], const bf16* Kh, const bf16* Vh, int P0, int qpos, int lane, const bf16x8 (&qf)[4], float negb,
                                       LAS unsigned char* vt, f32x16& o0, f32x16& o1, float& lsum) {
    LAS unsigned char* kslot = vt + 8192 + ((Q.ord + 1) & 1) * 4096;
    a_kstore(kv, kslot, lane); a_vstore(vv, vt + ((Q.ord + 1) & 1) * 4096, lane);
    a_kvload(kv, vv, Kh, Vh, Q.n3, P0, lane);
    f32x16 s_next; { KSet KA; a_kfrag(KA, kslot, lane); s_next = a_qk(KA, qf, negb); }
    const int range = Q.t < 6 ? 3 : (Q.t < 9 ? 2 : 1);
    if (range != wrange) { wrange = range; if (range == 3) a_periodic<3>(wp, P0, qpos, lane); else if (range == 2) a_periodic<2>(wp, P0, qpos, lane); else a_periodic<1>(wp, P0, qpos, lane); }
    bf16x8 pf0, pf1;
    if (range == 3) a_softmax<3>(s_cur, Q.t, P0, qpos, lane, wp, pf0, pf1, lsum);
    else if (range == 2) a_softmax<2>(s_cur, Q.t, P0, qpos, lane, wp, pf0, pf1, lsum);
    else a_softmax<1>(s_cur, Q.t, P0, qpos, lane, wp, pf0, pf1, lsum);
    a_pv(pf0, pf1, lane, vt + (Q.ord & 1) * 4096, o0, o1);
    s_cur = s_next;
    Q.t = Q.n1; Q.n1 = Q.n2; Q.n2 = Q.n3; Q.n3 = a_next(Q.n3, Q.f2, Q.f1); ++Q.ord;
}
__device__ __forceinline__ void unitA(Frame& F, const Args& A, int ua, float negb) {
    const int b = ua >> 6, g = (ua >> 3) & 7, r = ua & 7;
    int lane = (int)threadIdx.x & 63; asm volatile("" : "+v"(lane));
    const int h = F.wave, i = lane & 31, hi = lane >> 5;
    const int P0 = 256 * g + r, qpos = P0 + 8 * i;
    const size_t rowb = (size_t)b * SEQ;
    const bf16* Qp = ((bf16*)(F.ws + WS_Q)) + (rowb + qpos) * 512 + 64 * h + 8 * hi;
    bf16x8 qf[4];
#pragma unroll
    for (int kk = 0; kk < 4; ++kk) qf[kk] = *(const bf16x8*)(Qp + 16 * kk);
    const bf16* Kh = ((bf16*)(F.ws + WS_K)) + rowb * 512 + 64 * h; const bf16* Vh = ((bf16*)(F.ws + WS_V)) + rowb * 512 + 64 * h;
    LAS unsigned char* vt = F.lds + RING_OFF + h * 16384;
    f32x16 o0, o1;
#pragma unroll
    for (int q = 0; q < 16; ++q) { o0[q] = 0.f; o1[q] = 0.f; }
    float lsum = 0.f;
    int f3 = 0, f2 = 0, f1 = 0;
    while (f3 < 6 && P0 - 2048 + 256 * f3 + 248 < 0) ++f3;
    while (f2 < 3 && P0 - 512 + 128 * f2 + 124 < 0) ++f2;
    while (f1 < 12 && P0 - 128 + 32 * f1 + 31 < 0) ++f1;
    ASeq Q; Q.f2 = f2; Q.f1 = f1; Q.ord = 0;
    Q.t = f3 < 6 ? f3 : (f2 < 3 ? 6 + f2 : 9 + f1); Q.n1 = a_next(Q.t, f2, f1); Q.n2 = a_next(Q.n1, f2, f1); Q.n3 = a_next(Q.n2, f2, f1);
    v4u kv[4], vv[4], kw[4], vw[4];
    a_kvload(kv, vv, Kh, Vh, Q.t, P0, lane);
    a_kstore(kv, vt + 8192, lane); a_vstore(vv, vt, lane);
    a_kvload(kv, vv, Kh, Vh, Q.n1, P0, lane); a_kvload(kw, vw, Kh, Vh, Q.n2, P0, lane);
    f32x16 s_cur; { KSet K0; a_kfrag(K0, vt + 8192, lane); s_cur = a_qk(K0, qf, negb); }
    const int ntile = (6 - f3) + (3 - f2) + (12 - f1);
    int wrange = 0; float wp[16];
#pragma unroll
    for (int q = 0; q < 16; ++q) wp[q] = 0.f;
#pragma unroll 1
    for (int k = 0; k + 1 < ntile; k += 2) { a_step(Q, kv, vv, s_cur, wrange, wp, Kh, Vh, P0, qpos, lane, qf, negb, vt, o0, o1, lsum); a_step(Q, kw, vw, s_cur, wrange, wp, Kh, Vh, P0, qpos, lane, qf, negb, vt, o0, o1, lsum); }
    if (ntile & 1) a_step(Q, kv, vv, s_cur, wrange, wp, Kh, Vh, P0, qpos, lane, qf, negb, vt, o0, o1, lsum);
    const float lt = lsum + __shfl_xor(lsum, 32), inv = 1.0f / lt;
    float ssq = 0.f;
#pragma unroll
    for (int q = 0; q < 16; ++q) { o0[q] *= inv; o1[q] *= inv; ssq += o0[q] * o0[q] + o1[q] * o1[q]; }
    ssq += __shfl_xor(ssq, 32);
    LAS float* RED = (LAS float*)(F.lds + RED_OFF);
    if (hi == 0) RED[h * 32 + i] = ssq;
    __syncthreads();
    float tot = 0.f;
#pragma unroll
    for (int w = 0; w < 8; ++w) tot += RED[w * 32 + i];
    const float rr = 1.0f / sqrtf(tot * (1.0f / 512.0f) + EPS);
    char* mixb = (char*)(F.ws + WS_MIX); const int mrow = (int)rowb + qpos;
#pragma unroll
    for (int db = 0; db < 2; ++db)
#pragma unroll
        for (int rq = 0; rq < 4; ++rq) { const int d0 = 32 * db + 8 * rq + 4 * hi; const f32x4 gg = *(const f32x4*)(A.in[13] + 64 * h + d0);
            const float a0 = (db ? o1[4 * rq] : o0[4 * rq]) * rr * gg.x, a1 = (db ? o1[4 * rq + 1] : o0[4 * rq + 1]) * rr * gg.y, a2 = (db ? o1[4 * rq + 2] : o0[4 * rq + 2]) * rr * gg.z, a3 = (db ? o1[4 * rq + 3] : o0[4 * rq + 3]) * rr * gg.w;
            v2u w; w.x = pk2(a0, a1); w.y = pk2(a2, a3); *(v2u*)(mixb + pg8::img_off(mrow, 512 + 64 * h + d0, DM / 64)) = w; }
    __syncthreads();
}

__device__ __forceinline__ void unitB(Frame& F, const Args& A, int ub) {
    int lane = (int)threadIdx.x & 63; asm volatile("" : "+v"(lane));
    const int h = F.wave, il = lane & 31, hi = lane >> 5;
    const size_t R0 = (size_t)ub * 128;
    LAS unsigned char* vn = F.lds + RING_OFF + h * 16384;
    const bf16* Wh = ((bf16*)(F.ws + WS_WS)) + (size_t)h * 128 * 128 + (size_t)il * 128 + 8 * hi;
    bf16x8 wf[20];
#pragma unroll
    for (int ib = 0; ib < 4; ++ib)
#pragma unroll
        for (int kk = 0; kk < 2 * ib + 2; ++kk) wf[ib * (ib + 1) + kk] = *(const bf16x8*)(Wh + (size_t)ib * 32 * 128 + 16 * kk);
    { const int jl = lane >> 3, ch = lane & 7;
      v4u gvr[16]; float s1[16], s2[16];
#pragma unroll
      for (int it = 0; it < 16; ++it) { const size_t row = R0 + jl + 8 * it;
          gvr[it] = *(const v4u*)(((bf16*)(F.ws + WS_GV)) + row * 512 + 64 * h + 8 * ch);
          s1[it] = __hip_atomic_load(((float*)F.ws + CW_ST1) + row, RLX_AGENT); s2[it] = __hip_atomic_load(((float*)F.ws + CW_ST2) + row, RLX_AGENT); }
      f32x4 lg0 = *(const f32x4*)(A.in[6] + 64 * h + 8 * ch), lg1 = *(const f32x4*)(A.in[6] + 64 * h + 8 * ch + 4), lb0 = *(const f32x4*)(A.in[7] + 64 * h + 8 * ch), lb1 = *(const f32x4*)(A.in[7] + 64 * h + 8 * ch + 4);
      __builtin_amdgcn_sched_barrier(0);
#pragma unroll
      for (int it = 0; it < 16; ++it) { const int j = jl + 8 * it; const v4u gv = gvr[it];
          const float mu = s1[it] * (1.0f / 512.0f), var = s2[it] * (1.0f / 512.0f) - mu * mu, rstd = 1.0f / sqrtf(var + EPS);
          v4u o;
          o.x = pk2((bf_lo(gv.x) - mu) * rstd * lg0.x + lb0.x, (bf_hi(gv.x) - mu) * rstd * lg0.y + lb0.y); o.y = pk2((bf_lo(gv.y) - mu) * rstd * lg0.z + lb0.z, (bf_hi(gv.y) - mu) * rstd * lg0.w + lb0.w);
          o.z = pk2((bf_lo(gv.z) - mu) * rstd * lg1.x + lb1.x, (bf_hi(gv.z) - mu) * rstd * lg1.y + lb1.y); o.w = pk2((bf_lo(gv.w) - mu) * rstd * lg1.z + lb1.z, (bf_hi(gv.w) - mu) * rstd * lg1.w + lb1.w);
          *(LAS v4u*)(vn + j * 128 + ch * 16) = o; } }
    f32x16 acc[4][2];
#pragma unroll
    for (int ib = 0; ib < 4; ++ib)
#pragma unroll
        for (int db = 0; db < 2; ++db)
#pragma unroll
            for (int q = 0; q < 16; ++q) acc[ib][db][q] = 0.f;
    const int ii = lane & 15;
    const LAS unsigned char* vb = vn + (8 * hi + (ii >> 2)) * 128 + (16 * ((lane >> 4) & 1) + 4 * (ii & 3)) * 2;
#pragma unroll
    for (int ib = 0; ib < 4; ++ib) {
#pragma unroll
        for (int kk = 0; kk < 8; ++kk) if (kk < 2 * ib + 2) {
            const bf16x8 a0 = cat8(vtr(vb + kk * 2048), vtr(vb + kk * 2048 + 512)), a1 = cat8(vtr(vb + kk * 2048 + 64), vtr(vb + kk * 2048 + 64 + 512));
            acc[ib][0] = __builtin_amdgcn_mfma_f32_32x32x16_bf16(a0, wf[ib * (ib + 1) + kk], acc[ib][0], 0, 0, 0); acc[ib][1] = __builtin_amdgcn_mfma_f32_32x32x16_bf16(a1, wf[ib * (ib + 1) + kk], acc[ib][1], 0, 0, 0); }
    }
    __builtin_amdgcn_sched_barrier(0);
    v2u uur[4][8];
#pragma unroll
    for (int ib = 0; ib < 4; ++ib)
#pragma unroll
        for (int db = 0; db < 2; ++db)
#pragma unroll
            for (int rq = 0; rq < 4; ++rq) uur[ib][4 * db + rq] = *(const v2u*)(((bf16*)(F.ws + WS_U)) + (R0 + 32 * ib + il) * 512 + 64 * h + 32 * db + 8 * rq + 4 * hi);
    LAS float* RED = (LAS float*)(F.lds + RED_OFF);
#pragma unroll
    for (int ib = 0; ib < 4; ++ib) { const size_t row = R0 + 32 * ib + il; const float bsi = A.in[9][h * 128 + 32 * ib + il]; float ssq = 0.f;
#pragma unroll
        for (int db = 0; db < 2; ++db)
#pragma unroll
            for (int rq = 0; rq < 4; ++rq) { const v2u uu = uur[ib][4 * db + rq];
                float a0 = bf_lo(uu.x) * (acc[ib][db][4 * rq] + bsi), a1 = bf_hi(uu.x) * (acc[ib][db][4 * rq + 1] + bsi), a2 = bf_lo(uu.y) * (acc[ib][db][4 * rq + 2] + bsi), a3 = bf_hi(uu.y) * (acc[ib][db][4 * rq + 3] + bsi);
                acc[ib][db][4 * rq] = a0; acc[ib][db][4 * rq + 1] = a1; acc[ib][db][4 * rq + 2] = a2; acc[ib][db][4 * rq + 3] = a3; ssq += (a0 * a0 + a1 * a1) + (a2 * a2 + a3 * a3); }
        ssq += __shfl_xor(ssq, 32);
        if (hi == 0) RED[h * 128 + 32 * ib + il] = ssq; }
    __syncthreads();
#pragma unroll
    for (int ib = 0; ib < 4; ++ib) { const size_t row = R0 + 32 * ib + il; float tot = 0.f;
#pragma unroll
        for (int w = 0; w < 8; ++w) tot += RED[w * 128 + 32 * ib + il];
        const float rr = 1.0f / sqrtf(tot * (1.0f / 512.0f) + EPS);
        char* mixb = (char*)(F.ws + WS_MIX);
#pragma unroll
        for (int db = 0; db < 2; ++db)
#pragma unroll
            for (int rq = 0; rq < 4; ++rq) { const int d0 = 32 * db + 8 * rq + 4 * hi; const f32x4 gg = *(const f32x4*)(A.in[12] + 64 * h + d0);
                v2u w; w.x = pk2(acc[ib][db][4 * rq] * rr * gg.x, acc[ib][db][4 * rq + 1] * rr * gg.y); w.y = pk2(acc[ib][db][4 * rq + 2] * rr * gg.z, acc[ib][db][4 * rq + 3] * rr * gg.w); *(v2u*)(mixb + pg8::img_off((int)row, 64 * h + d0, DM / 64)) = w; } }
    __syncthreads();
}

template <int CTRL> __device__ __forceinline__ float dppf(float x) { return __builtin_bit_cast(float, __builtin_amdgcn_mov_dpp(__builtin_bit_cast(int, x), CTRL, 0xf, 0xf, true)); }
__device__ __forceinline__ float row16_sum(float v) { v += dppf<0xB1>(v); v += dppf<0x4E>(v); v += dppf<0x141>(v); v += dppf<0x128>(v); return v; }
__device__ __forceinline__ float dot4(f32x4 a, f32x4 b) { return (a.x * b.x + a.y * b.y) + (a.z * b.z + a.w * b.w); }
struct CState { f32x4 a[4]; float l[4]; };
__device__ __forceinline__ void c_row_t(const f32x4 k, const f32x4 v, int delta, const f32x4 qa, float negb, f32x4& a, float& l) {
    const float w = wgt(delta, 1 << 30);
    const float d = row16_sum(dot4(k, qa));
    const float p = w * __builtin_amdgcn_exp2f(d + negb);
    l += p; a += v * p;
}
struct CBuf { f32x4 k[8], v[8]; };
__device__ __forceinline__ void c_issue(CBuf& B, const float* kbase, const float* vbase, long rstride, int off) {
#pragma unroll
    for (int q = 0; q < 8; ++q) { B.k[q] = __builtin_nontemporal_load((const f32x4*)(kbase + (long)q * rstride + off)); B.v[q] = __builtin_nontemporal_load((const f32x4*)(vbase + (long)q * rstride + off)); }
}
__device__ __forceinline__ void c_consume(const CBuf& B, int delta0, int dstep, int tsel, const LAS float* qs, int off, float negb, CState& S) {
#pragma unroll
    for (int t = 0; t < 4; ++t) { if (tsel < 0 || tsel == t) {
        const f32x4 qa = *(const LAS f32x4*)(qs + t * 512 + off);
#pragma unroll
        for (int q = 0; q < 8; ++q) c_row_t(B.k[q], B.v[q], delta0 + q * dstep + t, qa, negb, S.a[t], S.l[t]); } }
}
__device__ __forceinline__ void c_desc(int b, int ws, long& idx, long& rstride, int& d0, int& dstep, int& tsel) {
    if (b < 4) { idx = LB - 128 + 32 * ws + 8 * b; rstride = 512; d0 = 128 - 32 * ws - 8 * b; dstep = -1; tsel = -1; }
    else { const int bb = b - 4, t = bb / 6, i = bb % 6, st = (i < 3) ? 4 : 16, j0 = 33 + 24 * ws + 8 * (i % 3); idx = LB + t - st * j0; rstride = -(long)st * 512; d0 = st * j0 - t; dstep = st; tsel = t; }
}
__device__ __forceinline__ void unitD(Frame& F, const Args& A, int n) {
    int tid = (int)threadIdx.x; asm volatile("" : "+v"(tid)); const int lane = tid & 63, w = F.wave;
    const size_t ms0 = (size_t)MP + 4 * n;
    LAS float* RED = (LAS float*)(F.lds + RED_OFF);
    {   const int col = tid, h = col >> 6;
        const float lg = A.in[6][col], lb = A.in[7][col];
        float vnv[4], a[4];
#pragma unroll
        for (int t = 0; t < 4; ++t) { const size_t row = ms0 + t; const float mu = __hip_atomic_load(((float*)F.ws + CW_ST1) + row, RLX_AGENT) * (1.0f / 512.0f), var = __hip_atomic_load(((float*)F.ws + CW_ST2) + row, RLX_AGENT) * (1.0f / 512.0f) - mu * mu, rstd = 1.0f / sqrtf(var + EPS);
            vnv[t] = (bf2f(((bf16*)(F.ws + WS_GV))[row * 512 + col]) - mu) * rstd * lg + lb; F.out[O_VC + (size_t)(4 * n + t) * 512 + col] = vnv[t]; }
#pragma unroll
        for (int i = 0; i < 4; ++i) { float s = A.in[9][h * 128 + i];
#pragma unroll
            for (int j = 0; j <= i; ++j) s += A.in[8][(size_t)(h * 128 + i) * 128 + j] * vnv[j];
            a[i] = bf2f(((bf16*)(F.ws + WS_U))[(ms0 + i) * 512 + col]) * s; const float sq = wave_sum(a[i] * a[i]); if (lane == 0) RED[w * 4 + i] = sq; }
        __syncthreads();
        const float go = A.in[12][col];
#pragma unroll
        for (int i = 0; i < 4; ++i) { float tot = 0.f;
#pragma unroll
            for (int ww = 0; ww < 8; ++ww) tot += RED[ww * 4 + i];
            *(bf16*)((char*)(F.ws + WS_MIX) + pg8::img_off((int)ms0 + i, col, DM / 64)) = (bf16)f2bf(a[i] * (1.0f / sqrtf(tot * (1.0f / 512.0f) + EPS)) * go); }
        __syncthreads();
    }
}
__device__ __forceinline__ void unitC(Frame& F, const Args& A, int n, float negb) {
    int tid = (int)threadIdx.x; asm volatile("" : "+v"(tid)); const int lane = tid & 63, w = F.wave;
    const size_t ms0 = (size_t)MP + 4 * n;
    LAS float* RED = (LAS float*)(F.lds + RED_OFF);
    CState S;
    const float* ck = A.in[2] + (size_t)n * LB * 512; const float* cv = A.in[3] + (size_t)n * LB * 512;
    const int half = w >> 2, ws = w & 3, off = 256 * half + 4 * lane;
    CBuf X, Y;
    { long idx, rs; int d0, ds, ts; c_desc(0, ws, idx, rs, d0, ds, ts); c_issue(X, ck + idx * 512, cv + idx * 512, rs, off); }
    LAS float* qs = (LAS float*)(F.lds + RING_OFF + 73728);
#pragma unroll
    for (int t = 0; t < 4; ++t) { qs[t * 512 + tid] = bf2f(((bf16*)(F.ws + WS_Q))[(ms0 + t) * 512 + tid]); S.a[t] = (f32x4){0.f, 0.f, 0.f, 0.f}; S.l[t] = 0.f; }
    __syncthreads();
#pragma unroll 1
    for (int b = 0; b < 28; b += 2) {
        long idx, rs; int d0, ds, ts, d1, ds1, ts1;
        c_desc(b + 1, ws, idx, rs, d1, ds1, ts1); c_issue(Y, ck + idx * 512, cv + idx * 512, rs, off);
        __builtin_amdgcn_sched_barrier(0);
        c_desc(b, ws, idx, rs, d0, ds, ts); c_consume(X, d0, ds, ts, qs, off, negb, S);
        __builtin_amdgcn_sched_barrier(0);
        if (b + 2 < 28) { c_desc(b + 2, ws, idx, rs, d0, ds, ts); c_issue(X, ck + idx * 512, cv + idx * 512, rs, off); }
        __builtin_amdgcn_sched_barrier(0);
        c_consume(Y, d1, ds1, ts1, qs, off, negb, S);
        __builtin_amdgcn_sched_barrier(0);
    }
    {   const f32x4 k = *(const f32x4*)(F.out + O_KS + (size_t)(4 * n + ws) * 512 + off), v = *(const f32x4*)(F.out + O_VS + (size_t)(4 * n + ws) * 512 + off);
#pragma unroll
        for (int t = 0; t < 4; ++t) { const f32x4 qa = *(const LAS f32x4*)(qs + t * 512 + off); c_row_t(k, v, t - ws, qa, negb, S.a[t], S.l[t]); } }
    LAS float* racc = (LAS float*)(F.lds + RING_OFF); LAS float* rl = (LAS float*)(F.lds + RING_OFF + 65536);
#pragma unroll
    for (int t = 0; t < 4; ++t) { *(LAS f32x4*)(racc + (ws * 4 + t) * 512 + off) = S.a[t]; if ((lane & 15) == 0) rl[(ws * 4 + t) * 8 + 4 * half + (lane >> 4)] = S.l[t]; }
    __syncthreads();
    {   const int col = tid, h = col >> 6; float o[4];
#pragma unroll
        for (int t = 0; t < 4; ++t) { float num = 0.f, den = 0.f;
#pragma unroll
            for (int ww = 0; ww < 4; ++ww) { num += racc[(ww * 4 + t) * 512 + col]; den += rl[(ww * 4 + t) * 8 + h]; }
            o[t] = num / den; const float sq = wave_sum(o[t] * o[t]); if (lane == 0) RED[w * 4 + t] = sq; }
        __syncthreads();
        const float go = A.in[13][col];
#pragma unroll
        for (int t = 0; t < 4; ++t) { float tot = 0.f;
#pragma unroll
            for (int ww = 0; ww < 8; ++ww) tot += RED[ww * 4 + t];
            *(bf16*)((char*)(F.ws + WS_MIX) + pg8::img_off((int)ms0 + t, 512 + col, DM / 64)) = (bf16)f2bf(o[t] * (1.0f / sqrtf(tot * (1.0f / 512.0f) + EPS)) * go); }
        __syncthreads();
    }
}
constexpr int NU_Q = 16 + 64 + 16 + 16;
static_assert(NDEC == 8 * 16 && NBATCH == 8, "queue split");
__device__ __forceinline__ void p2_mixers(Frame& F, const Args& A) {
    const float gqm = wave_max(fabsf(A.in[10][F.lane])), gkm = wave_max(fabsf(A.in[11][F.lane]));
    const float negb = __builtin_bit_cast(float, __builtin_amdgcn_readfirstlane(__builtin_bit_cast(int, -(8.0f * 1.4426950408889634f * 1.02f) * gqm * gkm)));
    const int myq = (int)(xb_xcc_id() & 7u);
#if PROBE_KIND == 6
    const unsigned long long pq0 = __builtin_amdgcn_s_memrealtime();
#endif
#pragma unroll 1
    for (int qq = 0; qq < 8; ++qq) {
        const int q = (myq + qq) & 7;
        for (;;) {
            if (threadIdx.x == 0) F.MISC[0] = __hip_atomic_fetch_add(F.ctl + CW_QUEUE + 64 * q, 1u, RLX_AGENT);
            __syncthreads();
            const int k = (int)F.MISC[0];
            __syncthreads();
            if (k >= NU_Q) break;
#if PROBE_KIND == 6
            const unsigned long long u0 = __builtin_amdgcn_s_memrealtime(); const int kind = k < 16 ? 0 : (k < 72 ? 1 : (k < 88 ? 2 : (k < 96 ? 1 : 3)));
#endif
            if (k < 16) unitC(F, A, 16 * q + k, negb);
            else if (k < 72) unitA(F, A, 64 * q + 8 * (7 - ((k - 16) >> 3)) + ((k - 16) & 7), negb);
            else if (k < 88) unitB(F, A, 16 * q + (k - 72));
            else if (k < 96) unitA(F, A, 64 * q + (k - 88), negb);
            else unitD(F, A, 16 * q + (k - 96));
#if PROBE_KIND == 6
            if (blockIdx.x == PROBE_BLK && threadIdx.x == 0 && kind == PROBE_SUB && F.MISC[24] == 0u) F.MISC[24] = (unsigned)(__builtin_amdgcn_s_memrealtime() - u0);
            if (threadIdx.x == 0 && ((PROBE_SUB == 8 && kind == 2) || (PROBE_SUB == 9 && kind == 3))) { __hip_atomic_fetch_add(F.ctl + 2048, (unsigned)(__builtin_amdgcn_s_memrealtime() - u0), RLX_AGENT); __hip_atomic_fetch_add(F.ctl + 2049, 1u, RLX_AGENT); }
            if (threadIdx.x == 0 && kind == 1 && (PROBE_SUB == 5 || (PROBE_SUB == 6 && u0 - pq0 < 4000ull) || (PROBE_SUB == 7 && u0 - pq0 >= 4000ull && u0 - pq0 < 9000ull))) { __hip_atomic_fetch_add(F.ctl + 2048, (unsigned)(__builtin_amdgcn_s_memrealtime() - u0), RLX_AGENT); __hip_atomic_fetch_add(F.ctl + 2049, 1u, RLX_AGENT); }
#endif
        }
    }
#if PROBE_KIND == 6
    if (blockIdx.x == PROBE_BLK && threadIdx.x == 0 && PROBE_SUB == 4) F.MISC[24] = (unsigned)(__builtin_amdgcn_s_memrealtime() - pq0);
    if (threadIdx.x == 0 && PROBE_SUB == 10) { __hip_atomic_fetch_max(F.ctl + 2048, (unsigned)(__builtin_amdgcn_s_memrealtime() - pq0), RLX_AGENT); __hip_atomic_fetch_add(F.ctl + 2049, 0u, RLX_AGENT); if (blockIdx.x == 0) __hip_atomic_store(F.ctl + 2049, 1u, RLX_AGENT); }
#endif
}

template <int K, int MODE>
__device__ __forceinline__ void skinny_tile(Frame& F, const Args& A, const bf16* Am  , const bf16* Bt  ) {
    int lane = (int)threadIdx.x & 63; asm volatile("" : "+v"(lane));
    const int w = F.wave, il = lane & 31, hi = lane >> 5;
    for (int tile = (int)blockIdx.x; tile < 256; tile += (int)gridDim.x) {
    const int r0 = 64 * (tile >> 5), c0 = 32 * (tile & 31);
    constexpr int KW = K / 8, NK = KW / 16;
    const char* ab = (const char*)Am; const char* bb = (const char*)Bt; const int arow = MP + r0 + il, brow = c0 + il, kc0 = w * KW + 8 * hi;
    f32x16 acc0, acc1;
#pragma unroll
    for (int q = 0; q < 16; ++q) { acc0[q] = 0.f; acc1[q] = 0.f; }
    constexpr int CH = (NK % 8 == 0) ? 8 : 11;
    static_assert(NK % CH == 0, "skinny_tile: K slice");
#pragma unroll 1
    for (int k0 = 0; k0 < NK; k0 += CH) {
        bf16x8 bf[CH], a0[CH], a1[CH];
#pragma unroll
        for (int c = 0; c < CH; ++c) { const int kc = kc0 + 16 * (k0 + c); bf[c] = *(const bf16x8*)(bb + pg8::img_off_b(brow, kc, K / 64)); a0[c] = *(const bf16x8*)(ab + pg8::img_off(arow, kc, K / 64)); a1[c] = *(const bf16x8*)(ab + pg8::img_off(arow + 32, kc, K / 64)); }
#pragma unroll
        for (int c = 0; c < CH; ++c) { acc0 = __builtin_amdgcn_mfma_f32_32x32x16_bf16(bf[c], a0[c], acc0, 0, 0, 0); acc1 = __builtin_amdgcn_mfma_f32_32x32x16_bf16(bf[c], a1[c], acc1, 0, 0, 0); }
    }
    LAS float* red = (LAS float*)(F.lds + RING_OFF);
#pragma unroll
    for (int q = 0; q < 16; ++q) { red[((w * 2 + 0) * 16 + q) * 64 + lane] = acc0[q]; red[((w * 2 + 1) * 16 + q) * 64 + lane] = acc1[q]; }
    __syncthreads();
    const int rb = w >> 2, qg = w & 3;
    f32x4 v = (f32x4){0.f, 0.f, 0.f, 0.f};
#pragma unroll
    for (int ww = 0; ww < 8; ++ww)
#pragma unroll
        for (int j = 0; j < 4; ++j) v[j] += red[((ww * 2 + rb) * 16 + 4 * qg + j) * 64 + lane];
    const int srow = r0 + 32 * rb + il, col = c0 + 8 * qg + 4 * hi;
    float* yp = F.out + O_Y + (size_t)(MP + srow) * DM + col;
    if (MODE == 0) {
        const f32x4 x = *(const f32x4*)(A.in[1] + (size_t)srow * DM + col); v = v + x;
        v2u o; o.x = pk2(v[0], v[1]); o.y = pk2(v[2], v[3]); *(v2u*)((char*)(F.ws + WS_X1B) + pg8::img_off(MP + srow, col, DM / 64)) = o;
        float s = (v[0] * v[0] + v[1] * v[1]) + (v[2] * v[2] + v[3] * v[3]); s += __shfl_xor(s, 32);
        if (hi == 0) atomicAdd((float*)F.ws + CW_SS + MP + srow, s);
    } else {
        const v2u xb = *(const v2u*)((const char*)(F.ws + WS_X1B) + pg8::img_off(MP + srow, col, DM / 64)); *(f32x4*)yp = v + (f32x4){bf_lo(xb.x), bf_hi(xb.x), bf_lo(xb.y), bf_hi(xb.y)};
    }
    __syncthreads();
    }
}
#ifndef PROBE_KIND
#define PROBE_KIND 0
#endif
#ifndef PROBE_PH
#define PROBE_PH 2
#endif
#ifndef PROBE_MUL
#define PROBE_MUL 4
#endif
#ifndef PROBE_BLK
#define PROBE_BLK 0
#endif
#ifndef PROBE_SUB
#define PROBE_SUB 0
#endif
__global__ void __launch_bounds__(NWAVES * 64, 2) hymba_fwd(Args args) {
    unsigned long long pr_t0 = 0, pr_dt = 0;
#define PR_BEGIN(k) do { if (PROBE_KIND == 1 && PROBE_PH == (k)) pr_t0 = __builtin_amdgcn_s_memrealtime(); } while (0)
#define PR_END(k) do { if (PROBE_KIND == 1 && PROBE_PH == (k)) pr_dt = __builtin_amdgcn_s_memrealtime() - pr_t0; } while (0)
    extern __shared__ __attribute__((aligned(16))) unsigned char lds[];
    Frame F;
    F.lds = (LAS unsigned char*)lds;
    F.MISC = (volatile LAS unsigned*)(F.lds + MISC_OFF);
    F.tid = threadIdx.x; F.lane = F.tid & 63; F.wave = __builtin_amdgcn_readfirstlane(F.tid >> 6);
    F.G = gridDim.x; { const int bx = blockIdx.x; F.vcu = (F.G % 8 == 0) ? (bx % 8) * (F.G / 8) + bx / 8 : bx; }
    unsigned char* ws = args.ws;
    F.ctl = (gu32*)(ws + WS_CTL); F.ws = ws; F.out = args.out;
    for (int u = F.tid; u < (LDS_BYTES - LDSCTL_OFF) / 4; u += NWAVES * 64) ((LAS unsigned*)(F.lds + LDSCTL_OFF))[u] = 0u;
    __syncthreads();
    XcdBarrier bar; bar.bar = (unsigned*)(F.ctl + CW_BAR); bar.x = 0; bar.st = nullptr;
    if (N_LAUNCHES != PER_PHASE) bar = xcd_barrier_post((unsigned*)(F.ctl + CW_BAR), F.MISC + 8);
#define GRID_BAR(seam) do { if (N_LAUNCHES == PER_PHASE) { if (F.tid == 0) __hip_atomic_store(F.ctl + CW_TMO, 0xBADBA0u | (unsigned)(seam), RLX_AGENT); } else { xcd_barrier(bar); } } while (0)
#if PROBE_KIND == 5
    if (F.tid == 0) __hip_atomic_store(F.ctl + 2048 + blockIdx.x, (unsigned)__builtin_amdgcn_s_memrealtime(), RLX_AGENT);
#endif
    const int lo = args.ph_lo, hi = args.ph_hi;
#define IN(k) (lo <= (k) && (k) < hi)
#define BOTH(k) (IN(k) && IN((k) + 1))
    PR_BEGIN(0);
    if (IN(0)) { p0_prologue(F, args); PR_BEGIN(10); if (BOTH(0)) GRID_BAR(0); PR_END(10); }
#if PROBE_KIND == 5
    if (blockIdx.x == 0 && F.tid == 0) { unsigned mn = 0xffffffffu, mx = 0u; const unsigned t0w = __hip_atomic_load(F.ctl + 2048, RLX_AGENT); for (int i = 0; i < (int)gridDim.x; ++i) { const unsigned v = __hip_atomic_load(F.ctl + 2048 + i, RLX_AGENT) - t0w + 0x40000000u; mn = v < mn ? v : mn; mx = v > mx ? v : mx; } F.MISC[24] = mx - mn; }
#endif
    PR_END(0);
    PR_BEGIN(1);
    if (IN(1)) {
        pg8::Gemm g{(const bf16*)(ws + WS_XN), (const bf16*)(ws + WS_WIN), M, NIN, DM}; pg8::StaticOrder S; S.init(M, NIN, F.G, (int)blockIdx.x);
        pg8::EpiIn E{ws, args.out, args.in[10], args.in[11]};
        pg8::gemm_phase<pg8::EpiIn, pg8::StaticOrder, PG8_ALIGN, PG8_SP2>(F.lds + RING_OFF, g, S, E);
        conv_late(F, args, (M / 256) * (NIN / 256), I_EARLY, I_GU_END);
        if (BOTH(1)) GRID_BAR(1);
    }
    PR_END(1);
    PR_BEGIN(2);
    if (IN(2)) { p2_mixers(F, args); if (BOTH(2)) GRID_BAR(2); }
    PR_END(2);
#if PROBE_KIND == 6
    if (PROBE_SUB >= 5 && blockIdx.x == PROBE_BLK && F.tid == 0) { const unsigned sm = __hip_atomic_load(F.ctl + 2048, RLX_AGENT), cn = __hip_atomic_load(F.ctl + 2049, RLX_AGENT); F.MISC[24] = cn ? sm / cn : 0u; }
#endif
    PR_BEGIN(3);
    if (IN(3)) {
        pg8::Gemm g{(const bf16*)(ws + WS_MIX), (const bf16*)(ws + WS_WO), MP, DM, DM}; pg8::StaticOrder S; S.init(MP, DM, F.G, (int)blockIdx.x);
        pg8::EpiWo E{args.in[4], ws};
        pg8::gemm_phase<pg8::EpiWo, pg8::StaticOrder, PG8_ALIGN, PG8_SP2>(F.lds + RING_OFF, g, S, E);
        skinny_tile<DM, 0>(F, args, (const bf16*)(ws + WS_MIX), (const bf16*)(ws + WS_WO));
        if (BOTH(3)) GRID_BAR(3);
    }
    PR_END(3);
    PR_BEGIN(4);
    if (IN(4)) {
        pg8::Gemm g{(const bf16*)(ws + WS_X1B), (const bf16*)(ws + WS_WGU), M, NGU, DM}; pg8::StaticOrder S; S.init(M, NGU, F.G, (int)blockIdx.x);
        pg8::EpiGU E{ws};
        pg8::gemm_phase<pg8::EpiGU, pg8::StaticOrder, PG8_ALIGN, PG8_SP2>(F.lds + RING_OFF, g, S, E);
        conv_late(F, args, (M / 256) * (NGU / 256), I_GU_END, I_ALL);
        if (BOTH(4)) GRID_BAR(4);
    }
    PR_END(4);
    PR_BEGIN(5);
    if (IN(5)) {
        pg8::Gemm g{(const bf16*)(ws + WS_H), (const bf16*)(ws + WS_WD), MP, DM, DFF}; pg8::StaticOrder S; S.init(MP, DM, F.G, (int)blockIdx.x);
        pg8::EpiDown E{args.out, ws};
        pg8::gemm_phase<pg8::EpiDown, pg8::StaticOrder, PG8_ALIGN, PG8_SP2>(F.lds + RING_OFF, g, S, E);
        skinny_tile<DFF, 1>(F, args, (const bf16*)(ws + WS_H), (const bf16*)(ws + WS_WD));
    }
    PR_END(5);
    if (PROBE_KIND != 0) {
        __syncthreads();
        if (PROBE_KIND != 1) pr_dt = (unsigned long long)F.MISC[24];
        if (blockIdx.x == PROBE_BLK && F.tid == 0) { const unsigned long long t = __builtin_amdgcn_s_memrealtime(); while (__builtin_amdgcn_s_memrealtime() - t < (unsigned long long)PROBE_MUL * pr_dt) __builtin_amdgcn_s_sleep(20); }
    }
#undef IN
#undef BOTH
}

extern "C" void kernel_launch(void* const* d_in, const int* in_sizes, int n_in, void* d_out, int out_size, void* d_ws, size_t ws_size, hipStream_t stream) {
    static int grid = 0;
    if (grid == 0) {
        if (n_in != 19 || in_sizes[0] != MP * DM || in_sizes[1] != MS * DM || (size_t)out_size != O_END || ws_size < WS_END) { fprintf(stderr, "kernel_launch: unexpected shapes (n_in %d, in0 %d, out %d, ws %zu); nothing launched\n", n_in, n_in > 0 ? in_sizes[0] : -1, out_size, ws_size); grid = -1; return; }
        int dev = 0, cus = 0, per_cu = 0;
        if (hipGetDevice(&dev) != hipSuccess || hipDeviceGetAttribute(&cus, hipDeviceAttributeMultiprocessorCount, dev) != hipSuccess) { grid = -1; return; }
        if (hipFuncSetAttribute((const void*)hymba_fwd, hipFuncAttributeMaxDynamicSharedMemorySize, LDS_BYTES) != hipSuccess) { fprintf(stderr, "kernel_launch: hipFuncSetAttribute failed\n"); grid = -1; return; }
        if (hipOccupancyMaxActiveBlocksPerMultiprocessor(&per_cu, (const void*)hymba_fwd, NWAVES * 64, LDS_BYTES) != hipSuccess || per_cu < 1) fprintf(stderr, "kernel_launch: occupancy query reports %d\n", per_cu);
        (void)hipGetLastError();
        grid = cus;
    }
    if (grid < 0) return;
    if (hipMemsetAsync((char*)d_ws + WS_CTL, 0, CTL_ZERO_BYTES, stream) != hipSuccess) { fprintf(stderr, "kernel_launch: hipMemsetAsync failed\n"); return; }
    Args a{};
    for (int i = 0; i < 19; ++i) a.in[i] = (const float*)d_in[i];
    a.out = (float*)d_out; a.ws = (unsigned char*)d_ws;
    for (int li = 0; li < N_LAUNCHES; ++li) {
        a.ph_lo = (N_LAUNCHES == PER_PHASE) ? li : 0; a.ph_hi = (N_LAUNCHES == PER_PHASE) ? li + 1 : PER_PHASE;
        hipLaunchKernelGGL(hymba_fwd, dim3(grid), dim3(NWAVES * 64), LDS_BYTES, stream, a);
        const hipError_t le = hipPeekAtLastError();
        if (le != hipSuccess) { fprintf(stderr, "kernel_launch: launch %d failed: %s\n", li, hipGetErrorName(le)); break; }
    }
}
```

```cpp
#include <hip/hip_runtime.h>
#include <cstdio>
#include <cstdint>
namespace pg8 {
#define PG8_LAS __attribute__((address_space(3)))
typedef unsigned short bf16_t;
typedef short bf16x8 __attribute__((ext_vector_type(8)));
typedef float f32x4 __attribute__((ext_vector_type(4)));
typedef unsigned u32x4 __attribute__((ext_vector_type(4)));
constexpr int BM = 256, BK = 64, HALF = 128, HTB = HALF * BK * 2  , STAGE_BYTES = 8 * HTB, NXCD = 8, WGM = 8;

__host__ __device__ __forceinline__ int lds_byte(int r, int c) { const int st = (r >> 4) * 2 + (c >> 5), rr = r & 15, cc = c & 31, ob = rr * 64 + cc * 2; return st * 1024 + (ob ^ (((ob >> 9) & 1) << 5)); }
__host__ __device__ __forceinline__ void stage_rc(int b, int& R, int& C) { const int st = b / 1024, sb = b % 1024, swz = sb ^ (((sb >> 9) & 1) << 5); R = (st >> 1) * 16 + swz / 64; C = (st & 1) * 32 + (swz % 64) / 2; }
__host__ __device__ __forceinline__ int perm32(int rho) { const int n = rho >> 4, i = rho & 15; return 8 * (i >> 2) + 4 * n + (i & 3); }

__host__ __device__ __forceinline__ int invperm32(int x) { return 16 * ((x >> 2) & 1) + 4 * (x >> 3) + (x & 3); }
__host__ __device__ __forceinline__ size_t img_off(int row, int col, int nkt) { return ((size_t)((row >> 7) * nkt + (col >> 6)) << 14) + (size_t)lds_byte(row & 127, col & 63); }
__host__ __device__ __forceinline__ size_t img_off_b(int row, int col, int nkt) { return img_off((row & ~31) | invperm32(row & 31), col, nkt); }
struct Unit { int pm, pn; };
struct Gemm { const bf16_t* A; const bf16_t* Bt; int M, N, K; };

struct StaticOrder {
    int nM, nN, nwg, G, c;
    __host__ __device__ void init(int M, int N, int G_, int c_) { nM = M / BM; nN = N / BM; nwg = nM * nN; G = G_; c = c_; }
    __host__ __device__ bool next(int i, Unit& u) const {
        const long L = (long)i * G + c; if (L >= nwg) return false;
        int wgid = (int)L; { const int q = nwg / NXCD, r = nwg % NXCD, xcd = wgid % NXCD, off = wgid / NXCD; wgid = (xcd < r ? xcd * (q + 1) : r * (q + 1) + (xcd - r) * q) + off; }
        const int nig = WGM * nN, gid = wgid / nig, fm = gid * WGM, gsz = (nM - fm) < WGM ? (nM - fm) : WGM;
        u.pm = fm + ((wgid % nig) % gsz); u.pn = (wgid % nig) / gsz; return true;
    }
    __device__ __forceinline__ void a_ready(const Unit&) const {}
    __device__ __forceinline__ void done(const Unit&) const {}
};

__device__ __forceinline__ unsigned cvt_pk_bf16(float lo, float hi) { unsigned r; asm volatile("v_cvt_pk_bf16_f32 %0, %1, %2" : "=v"(r) : "v"(lo), "v"(hi)); return r; }
typedef float f32x2 __attribute__((ext_vector_type(2)));
__device__ __forceinline__ float fast_exp2(float x) { return __builtin_amdgcn_exp2f(x); }
__device__ __forceinline__ float fast_rcp(float x) { return __builtin_amdgcn_rcpf(x); }
__device__ __forceinline__ float gelu_t(float x) { const float u = 0.7978845608028654f * (x + 0.044715f * x * x * x); return x * fast_rcp(1.0f + fast_exp2(-2.8853900817779268f * u)); }
__device__ __forceinline__ float silu_f(float x) { return x * fast_rcp(1.0f + fast_exp2(-1.4426950408889634f * x)); }
__device__ __forceinline__ float quad_sum(float s) { s += __shfl_xor(s, 16); s += __shfl_xor(s, 32); return s; }

constexpr size_t EW_U = 66u << 20, EW_GV = 83u << 20, EW_Q = 100u << 20, EW_K = 117u << 20, EW_V = 134u << 20, EW_X1B = 186u << 20, EW_H = 220u << 20;
constexpr int EC_ST1 = 16384, EC_ST2 = EC_ST1 + 16896, EC_SS = EC_ST2 + 16896, EC_RS = EC_SS + 16896;
constexpr size_t EW_XN = 32u << 20;
constexpr size_t EO_KP = (size_t)16896 * 1024, EO_VP = EO_KP + (size_t)16384 * 512, EO_KS = EO_VP + (size_t)16384 * 512, EO_VS = EO_KS + (size_t)512 * 512;
constexpr int XM_PROMPT = 16384;
constexpr float QSCALE = 0.125f * 1.4426950408889634f;

struct EpiIn {
    static constexpr bool PERM = true, AFTER_DRAIN = false;
    unsigned char* ws; float* out; const float *gq, *gk;
    __device__ __forceinline__ void operator()(const f32x4 (&acc)[2][2][4][2], const Unit& u, int wr, int wc, int fr, int fq) const {
        const int row0 = u.pm * BM + wr * 64 + fr; const int pn = u.pn;
        if (pn < 4) {
            bf16_t* dst = (bf16_t*)(ws + ((pn < 2) ? EW_U : EW_GV)); float* st1 = (float*)ws + EC_ST1; float* st2 = (float*)ws + EC_ST2; const int col0 = (pn & 1) * 256 + wc * 32 + 8 * fq; const bool stats = pn >= 2;
#pragma unroll
            for (int ai = 0; ai < 2; ++ai)
#pragma unroll
                for (int m = 0; m < 4; ++m) { const int row = row0 + ai * HALF + m * 16; bf16_t* rowp = dst + (size_t)row * 512 + col0; float s1 = 0.f, s2 = 0.f;
#pragma unroll
                    for (int bj = 0; bj < 2; ++bj) { f32x4 v0 = acc[ai][bj][m][0], v1 = acc[ai][bj][m][1];
#pragma unroll
                        for (int j = 0; j < 4; ++j) { v0[j] = gelu_t(v0[j]); v1[j] = gelu_t(v1[j]); }
                        s1 += (v0[0] + v0[1]) + (v0[2] + v0[3]) + (v1[0] + v1[1]) + (v1[2] + v1[3]);
                        s2 += (v0[0] * v0[0] + v0[1] * v0[1]) + (v0[2] * v0[2] + v0[3] * v0[3]) + (v1[0] * v1[0] + v1[1] * v1[1]) + (v1[2] * v1[2] + v1[3] * v1[3]);
                        u32x4 w; w.x = cvt_pk_bf16(v0[0], v0[1]); w.y = cvt_pk_bf16(v0[2], v0[3]); w.z = cvt_pk_bf16(v1[0], v1[1]); w.w = cvt_pk_bf16(v1[2], v1[3]);
                        *(u32x4*)(rowp + bj * HALF) = w; }
                    if (stats) { s1 = quad_sum(s1); s2 = quad_sum(s2); if (fq == 0) { atomicAdd(st1 + row, s1); atomicAdd(st2 + row, s2); } } }
        } else {
            const int sec = pn >> 1, head = 4 * (pn & 1) + wc; const bool prompt = u.pm < (XM_PROMPT / BM);
            bf16_t* dst = (bf16_t*)(ws + ((sec == 2) ? EW_Q : (sec == 3) ? EW_K : EW_V)); const float* gp = (sec == 2) ? gq : gk;
            float* fo = (sec == 2) ? nullptr : out + ((sec == 3) ? (prompt ? EO_KP : EO_KS) : (prompt ? EO_VP : EO_VS));
            f32x4 gv[2][2];
#pragma unroll
            for (int bj = 0; bj < 2; ++bj)
#pragma unroll
                for (int n = 0; n < 2; ++n) gv[bj][n] = (sec < 4) ? *(const f32x4*)(gp + 32 * bj + 8 * fq + 4 * n) : (f32x4){1.f, 1.f, 1.f, 1.f};
            const float post = (sec == 2) ? QSCALE : 1.0f;
#pragma unroll
            for (int ai = 0; ai < 2; ++ai)
#pragma unroll
                for (int m = 0; m < 4; ++m) { const int row = row0 + ai * HALF + m * 16; const int orow = prompt ? row : row - XM_PROMPT;
                    float ss = 0.f;
#pragma unroll
                    for (int bj = 0; bj < 2; ++bj)
#pragma unroll
                        for (int n = 0; n < 2; ++n) { const f32x4 x = acc[ai][bj][m][n]; ss += (x[0] * x[0] + x[1] * x[1]) + (x[2] * x[2] + x[3] * x[3]); }
                    ss = quad_sum(ss);
                    const float rr = (sec < 4) ? post * (1.0f / sqrtf(ss * (1.0f / 64.0f) + 1e-6f)) : 1.0f;
#pragma unroll
                    for (int bj = 0; bj < 2; ++bj) { const f32x4 v0 = acc[ai][bj][m][0] * rr * gv[bj][0], v1 = acc[ai][bj][m][1] * rr * gv[bj][1];
                        const int dcol = 64 * head + 32 * bj + 8 * fq;
                        u32x4 w; w.x = cvt_pk_bf16(v0[0], v0[1]); w.y = cvt_pk_bf16(v0[2], v0[3]); w.z = cvt_pk_bf16(v1[0], v1[1]); w.w = cvt_pk_bf16(v1[2], v1[3]);
                        *(u32x4*)(dst + (size_t)row * 512 + dcol) = w;
                        if (fo) { float* op = fo + (size_t)orow * 512 + dcol; if (prompt) { __builtin_nontemporal_store(v0, (f32x4*)op); __builtin_nontemporal_store(v1, (f32x4*)(op + 4)); } else { *(f32x4*)op = v0; *(f32x4*)(op + 4) = v1; } } } }
        }
    }
};
struct EpiWo {
    static constexpr bool PERM = true, AFTER_DRAIN = false;
    const float *ga; unsigned char* ws;
    __device__ __forceinline__ void operator()(const f32x4 (&acc)[2][2][4][2], const Unit& u, int wr, int wc, int fr, int fq) const {
        const int row0 = u.pm * BM + wr * 64 + fr; const int col0 = u.pn * BM + wc * 32 + 8 * fq;
        const char* xn = (const char*)(ws + EW_XN); const float* rs = (const float*)ws + EC_RS; bf16_t* x1b = (bf16_t*)(ws + EW_X1B); float* ss = (float*)ws + EC_SS;
        f32x4 gi[2][2];
#pragma unroll
        for (int bj = 0; bj < 2; ++bj)
#pragma unroll
            for (int n = 0; n < 2; ++n) { const f32x4 g = *(const f32x4*)(ga + col0 + bj * HALF + 4 * n); gi[bj][n] = (f32x4){1.0f / g[0], 1.0f / g[1], 1.0f / g[2], 1.0f / g[3]}; }
#pragma unroll
        for (int ai = 0; ai < 2; ++ai)
#pragma unroll
            for (int m = 0; m < 4; ++m) { const int row = row0 + ai * HALF + m * 16; float s = 0.f; const float rinv = 1.0f / rs[row];
#pragma unroll
                for (int bj = 0; bj < 2; ++bj) { const u32x4 xw = __builtin_nontemporal_load((const u32x4*)(xn + img_off(row, col0 + bj * HALF, 16)));
                    const f32x4 x0 = (f32x4){__builtin_bit_cast(float, xw.x << 16), __builtin_bit_cast(float, xw.x & 0xffff0000u), __builtin_bit_cast(float, xw.y << 16), __builtin_bit_cast(float, xw.y & 0xffff0000u)} * rinv * gi[bj][0];
                    const f32x4 x1 = (f32x4){__builtin_bit_cast(float, xw.z << 16), __builtin_bit_cast(float, xw.z & 0xffff0000u), __builtin_bit_cast(float, xw.w << 16), __builtin_bit_cast(float, xw.w & 0xffff0000u)} * rinv * gi[bj][1];
                    const f32x4 v0 = acc[ai][bj][m][0] + x0, v1 = acc[ai][bj][m][1] + x1;
                    s += (v0[0] * v0[0] + v0[1] * v0[1]) + (v0[2] * v0[2] + v0[3] * v0[3]) + (v1[0] * v1[0] + v1[1] * v1[1]) + (v1[2] * v1[2] + v1[3] * v1[3]);
                    u32x4 w; w.x = cvt_pk_bf16(v0[0], v0[1]); w.y = cvt_pk_bf16(v0[2], v0[3]); w.z = cvt_pk_bf16(v1[0], v1[1]); w.w = cvt_pk_bf16(v1[2], v1[3]);
                    *(u32x4*)((char*)x1b + img_off(row, col0 + bj * HALF, 16)) = w; }
                s = quad_sum(s); if (fq == 0) atomicAdd(ss + row, s); }
    }
};
struct EpiGU {
    static constexpr bool PERM = true, AFTER_DRAIN = false;
    unsigned char* ws;
    __device__ __forceinline__ void operator()(const f32x4 (&acc)[2][2][4][2], const Unit& u, int wr, int wc, int fr, int fq) const {
        const int row0 = u.pm * BM + wr * 64 + fr; const int col0 = u.pn * HALF + wc * 32 + 8 * fq; const float* ss = (const float*)ws + EC_SS; bf16_t* H = (bf16_t*)(ws + EW_H);
#pragma unroll
        for (int ai = 0; ai < 2; ++ai)
#pragma unroll
            for (int m = 0; m < 4; ++m) { const int row = row0 + ai * HALF + m * 16;
                const float r = 1.0f / sqrtf(__hip_atomic_load(ss + row, __ATOMIC_RELAXED, __HIP_MEMORY_SCOPE_AGENT) * (1.0f / 1024.0f) + 1e-6f);
                float a[8];
#pragma unroll
                for (int n = 0; n < 2; ++n)
#pragma unroll
                    for (int j = 0; j < 4; ++j) a[4 * n + j] = silu_f(acc[ai][0][m][n][j] * r) * (acc[ai][1][m][n][j] * r);
                u32x4 w; w.x = cvt_pk_bf16(a[0], a[1]); w.y = cvt_pk_bf16(a[2], a[3]); w.z = cvt_pk_bf16(a[4], a[5]); w.w = cvt_pk_bf16(a[6], a[7]);
                *(u32x4*)((char*)H + img_off(row, col0, 44)) = w; }
    }
};
struct EpiDown {
    static constexpr bool PERM = true, AFTER_DRAIN = false;
    float* y; const unsigned char* ws;
    __device__ __forceinline__ void operator()(const f32x4 (&acc)[2][2][4][2], const Unit& u, int wr, int wc, int fr, int fq) const {
        const int row0 = u.pm * BM + wr * 64 + fr; const int col0 = u.pn * BM + wc * 32 + 8 * fq; const char* x1b = (const char*)(ws + EW_X1B);
#pragma unroll
        for (int ai = 0; ai < 2; ++ai)
#pragma unroll
            for (int m = 0; m < 4; ++m) { const int row = row0 + ai * HALF + m * 16; const size_t off = (size_t)row * 1024 + col0;
#pragma unroll
                for (int bj = 0; bj < 2; ++bj) { const u32x4 xb = __builtin_nontemporal_load((const u32x4*)(x1b + img_off(row, col0 + bj * HALF, 16))); float* p = y + off + bj * HALF;
                    const f32x4 x0 = (f32x4){__builtin_bit_cast(float, xb.x << 16), __builtin_bit_cast(float, xb.x & 0xffff0000u), __builtin_bit_cast(float, xb.y << 16), __builtin_bit_cast(float, xb.y & 0xffff0000u)};
                    const f32x4 x1 = (f32x4){__builtin_bit_cast(float, xb.z << 16), __builtin_bit_cast(float, xb.z & 0xffff0000u), __builtin_bit_cast(float, xb.w << 16), __builtin_bit_cast(float, xb.w & 0xffff0000u)};
                    __builtin_nontemporal_store(acc[ai][bj][m][0] + x0, (f32x4*)p); __builtin_nontemporal_store(acc[ai][bj][m][1] + x1, (f32x4*)(p + 4)); } }
    }
};

template <class Epi, class Sched, bool ALIGN_EPI = false, bool SP2 = false>
__device__ __forceinline__ void gemm_phase(PG8_LAS unsigned char* lds, const Gemm g, const Sched& S, const Epi& E) {
    const int tid = threadIdx.x, wid = __builtin_amdgcn_readfirstlane(tid >> 6), lane = tid & 63, wr = wid >> 2, wc = wid & 3, fr = lane & 15, fq = lane >> 4;
    const int K = g.K, nt = K / BK;
    unsigned voffA[2], voffB[2];
#pragma unroll
    for (int i = 0; i < 2; ++i) { voffA[i] = (unsigned)(tid * 16 + i * 8192); voffB[i] = voffA[i]; }
    static_assert(Epi::PERM, "image layout: B images are written with the perm32 row order");
    const size_t kstep = (size_t)HTB;
    const size_t hstep = (size_t)HALF * K * 2;
    const size_t tstep = 2 * hstep;
    const unsigned ldsw = (unsigned)wid * 1024u;
    const int aoff = lds_byte(wr * 64 + fr, fq * 8), boff = lds_byte(wc * 32 + fr, fq * 8);
#define PG8_SA(b, h) (((b) * 2 + (h)) * HTB)
#define PG8_SB(b, h) ((4 + (b) * 2 + (h)) * HTB)
#define PG8_STAGE(bufoff, gbase, voff) do { _Pragma("unroll") for (int _i = 0; _i < 2; ++_i) \
        __builtin_amdgcn_global_load_lds((const unsigned*)((const char*)(gbase) + (voff)[_i]), (PG8_LAS unsigned*)(lds + (bufoff) + ldsw + _i * 8192), 16, 0, 0); } while (0)
#define PG8_LDA(dst, b, h) do { _Pragma("unroll") for (int m = 0; m < 4; ++m) _Pragma("unroll") for (int k = 0; k < 2; ++k) dst[m][k] = *(const PG8_LAS bf16x8*)(lds + PG8_SA(b, h) + aoff + m * 2048 + k * 1024); } while (0)
#define PG8_LDB(dst, b, h) do { _Pragma("unroll") for (int n = 0; n < 2; ++n) _Pragma("unroll") for (int k = 0; k < 2; ++k) dst[n][k] = *(const PG8_LAS bf16x8*)(lds + PG8_SB(b, h) + boff + n * 2048 + k * 1024); } while (0)
#define PG8_MMA(ai, bj, At, Bt) do { __builtin_amdgcn_s_setprio(1); _Pragma("unroll") for (int m = 0; m < 4; ++m) _Pragma("unroll") for (int n = 0; n < 2; ++n) _Pragma("unroll") for (int k = 0; k < 2; ++k) \
        acc[ai][bj][m][n] = __builtin_amdgcn_mfma_f32_16x16x32_bf16(Bt[n][k], At[m][k], acc[ai][bj][m][n], 0, 0, 0); __builtin_amdgcn_s_setprio(0); } while (0)
#define PG8_WAIT_V(n) asm volatile("s_waitcnt vmcnt(" #n ")" ::: "memory")
#define PG8_WAIT_L(n) asm volatile("s_waitcnt lgkmcnt(" #n ")" ::: "memory")
#define PG8_BAR __builtin_amdgcn_s_barrier()
#define PG8_SCHED __builtin_amdgcn_sched_barrier(0)
    Unit cur, nxt; int ui = 0;
    if (!S.next(0, cur)) return;
    f32x4 acc[2][2][4][2];
#pragma unroll
    for (int a = 0; a < 2; ++a)
#pragma unroll
        for (int b = 0; b < 2; ++b)
#pragma unroll
            for (int m = 0; m < 4; ++m)
#pragma unroll
                for (int n = 0; n < 2; ++n) acc[a][b][m][n] = (f32x4){0.f, 0.f, 0.f, 0.f};
    bf16x8 At[4][2], B0[2][2], B1[2][2];
    const char* cA = (const char*)g.A + (size_t)cur.pm * tstep; const char* cB = (const char*)g.Bt + (size_t)cur.pn * tstep;
    S.a_ready(cur);
    if constexpr (SP2) {
        PG8_STAGE(PG8_SB(0, 0), cB, voffB); PG8_STAGE(PG8_SB(0, 1), cB + hstep, voffB); PG8_STAGE(PG8_SA(0, 0), cA, voffA); PG8_STAGE(PG8_SA(0, 1), cA + hstep, voffA);
        if (wr == 1) PG8_BAR;
        PG8_WAIT_V(2); PG8_BAR;
        PG8_STAGE(PG8_SB(1, 0), cB + kstep, voffB); PG8_STAGE(PG8_SA(1, 0), cA + kstep, voffA); PG8_STAGE(PG8_SB(1, 1), cB + hstep + kstep, voffB);
        PG8_WAIT_V(6); PG8_BAR;
    } else {
        PG8_STAGE(PG8_SB(0, 0), cB, voffB); PG8_STAGE(PG8_SA(0, 0), cA, voffA); PG8_STAGE(PG8_SB(0, 1), cB + hstep, voffB); PG8_STAGE(PG8_SA(0, 1), cA + hstep, voffA);
        if (wr == 1) PG8_BAR;
        PG8_WAIT_V(4); PG8_BAR;
        PG8_STAGE(PG8_SB(1, 0), cB + kstep, voffB); PG8_STAGE(PG8_SA(1, 0), cA + kstep, voffA); PG8_STAGE(PG8_SB(1, 1), cB + hstep + kstep, voffB);
        PG8_WAIT_V(6); PG8_BAR;
    }
    for (;;) {
        const bool has_next = S.next(ui + 1, nxt);
        const char* nA = has_next ? (const char*)g.A + (size_t)nxt.pm * tstep : cA; const char* nB = has_next ? (const char*)g.Bt + (size_t)nxt.pn * tstep : cB;
        for (int t = 0; t < nt; t += 2) {
            const bool last = (t == nt - 2);
            const char* a1 = cA + (size_t)(t + 1) * kstep;
            const char* a2 = last ? nA : cA + (size_t)(t + 2) * kstep; const char* b2 = last ? nB : cB + (size_t)(t + 2) * kstep;
            const char* a3 = a2 + kstep; const char* b3 = b2 + kstep;
            if (last && has_next) S.a_ready(nxt);
            if constexpr (SP2) {
            PG8_LDB(B0, 0, 0); PG8_LDB(B1, 0, 1); PG8_SCHED; PG8_LDA(At, 0, 0); PG8_STAGE(PG8_SA(1, 1), a1 + hstep, voffA);
            PG8_WAIT_V(8); PG8_WAIT_L(0); PG8_BAR; PG8_MMA(0, 0, At, B0); PG8_MMA(0, 1, At, B1); PG8_BAR; PG8_SCHED;
            PG8_LDA(At, 0, 1); PG8_STAGE(PG8_SB(0, 0), b2, voffB); PG8_STAGE(PG8_SB(0, 1), b2 + hstep, voffB); PG8_STAGE(PG8_SA(0, 0), a2, voffA);
            PG8_WAIT_V(8); PG8_WAIT_L(0); PG8_BAR; PG8_MMA(1, 0, At, B0); PG8_MMA(1, 1, At, B1); PG8_BAR; PG8_SCHED;
            PG8_LDB(B0, 1, 0); PG8_LDB(B1, 1, 1); PG8_SCHED; PG8_LDA(At, 1, 0); PG8_STAGE(PG8_SA(0, 1), a2 + hstep, voffA);
            PG8_WAIT_V(8); PG8_WAIT_L(0); PG8_BAR; PG8_MMA(0, 0, At, B0); PG8_MMA(0, 1, At, B1); PG8_BAR; PG8_SCHED;
            PG8_LDA(At, 1, 1); PG8_STAGE(PG8_SB(1, 0), b3, voffB); PG8_STAGE(PG8_SB(1, 1), b3 + hstep, voffB); PG8_STAGE(PG8_SA(1, 0), a3, voffA);
            PG8_WAIT_V(8); PG8_WAIT_L(0); PG8_BAR; PG8_MMA(1, 0, At, B0); PG8_MMA(1, 1, At, B1); PG8_BAR; PG8_SCHED;
            } else {
            PG8_LDB(B0, 0, 0); PG8_SCHED; PG8_LDA(At, 0, 0); PG8_STAGE(PG8_SA(1, 1), a1 + hstep, voffA);
            PG8_WAIT_L(8); PG8_BAR; PG8_WAIT_L(0); PG8_MMA(0, 0, At, B0); PG8_BAR; PG8_SCHED;
            PG8_LDB(B1, 0, 1); PG8_STAGE(PG8_SB(0, 0), b2, voffB);
            PG8_BAR; PG8_WAIT_L(0); PG8_MMA(0, 1, At, B1); PG8_BAR;
            PG8_LDA(At, 0, 1); PG8_STAGE(PG8_SA(0, 0), a2, voffA);
            PG8_BAR; PG8_WAIT_L(0); PG8_MMA(1, 0, At, B0); PG8_BAR; PG8_SCHED;
            PG8_STAGE(PG8_SB(0, 1), b2 + hstep, voffB);
            PG8_WAIT_V(6); PG8_BAR; PG8_MMA(1, 1, At, B1); PG8_BAR;
            PG8_LDB(B0, 1, 0); PG8_SCHED; PG8_LDA(At, 1, 0); PG8_STAGE(PG8_SA(0, 1), a2 + hstep, voffA);
            PG8_WAIT_L(8); PG8_BAR; PG8_WAIT_L(0); PG8_MMA(0, 0, At, B0); PG8_BAR; PG8_SCHED;
            PG8_LDB(B1, 1, 1); PG8_STAGE(PG8_SB(1, 0), b3, voffB);
            PG8_BAR; PG8_WAIT_L(0); PG8_MMA(0, 1, At, B1); PG8_BAR;
            PG8_LDA(At, 1, 1); PG8_STAGE(PG8_SA(1, 0), a3, voffA);
            PG8_BAR; PG8_WAIT_L(0); PG8_MMA(1, 0, At, B0); PG8_BAR; PG8_SCHED;
            PG8_STAGE(PG8_SB(1, 1), b3 + hstep, voffB);
            PG8_WAIT_V(6); PG8_BAR; PG8_MMA(1, 1, At, B1); PG8_BAR;
            }
        }
        if constexpr (ALIGN_EPI) { if (wr == 0) PG8_BAR; }
        if constexpr (!Epi::AFTER_DRAIN) { E(acc, cur, wr, wc, fr, fq); S.done(cur); }
        if (!has_next) break;
#pragma unroll
        for (int a = 0; a < 2; ++a)
#pragma unroll
            for (int b = 0; b < 2; ++b)
#pragma unroll
                for (int m = 0; m < 4; ++m)
#pragma unroll
                    for (int n = 0; n < 2; ++n) acc[a][b][m][n] = (f32x4){0.f, 0.f, 0.f, 0.f};
        cur = nxt; cA = nA; cB = nB; ++ui;
        if constexpr (ALIGN_EPI) { if (wr == 1) PG8_BAR; }
    }
    PG8_WAIT_V(0);
    if constexpr (!ALIGN_EPI) { if (wr == 0) PG8_BAR; }
    PG8_BAR;
    if constexpr (Epi::AFTER_DRAIN) { E.fused(acc, cur, wr, wc, fr, fq, lds, wid, lane); S.done(cur); }
#undef PG8_SA
#undef PG8_SB
#undef PG8_STAGE
#undef PG8_LDA
#undef PG8_LDB
#undef PG8_MMA
#undef PG8_WAIT_V
#undef PG8_WAIT_L
#undef PG8_BAR
#undef PG8_SCHED
}
}
#ifndef PG8_SP2
#define PG8_SP2 true
#endif
#ifndef PG8_ALIGN
#define PG8_ALIGN true
#endif
#ifndef MK_N_LAUNCHES
#define MK_N_LAUNCHES 1
#endif
constexpr int NWAVES = 8;
constexpr int N_LAUNCHES = MK_N_LAUNCHES;
constexpr int PER_PHASE = 6;

constexpr int DM = 1024, SEQ = 2048, NBATCH = 8, MP = NBATCH * SEQ, NDEC = 128, TDEC = 4, MS = NDEC * TDEC, M = MP + MS;
constexpr int WA = 512, NIN = 2560, DFF = 2816, NGU = 2 * DFF, LB = 2048;
constexpr float EPS = 1e-6f;
constexpr size_t O_Y = 0, O_KP = (size_t)M * DM, O_VP = O_KP + (size_t)MP * 512, O_KS = O_VP + (size_t)MP * 512, O_VS = O_KS + (size_t)MS * 512, O_VC = O_VS + (size_t)MS * 512, O_END = O_VC + (size_t)MS * 512;
constexpr size_t MiB = 1u << 20;
constexpr size_t WS_CTL = 0, CTL_ZERO_BYTES = 1 * MiB;
constexpr size_t WS_WIN = 2 * MiB, WS_WO = 8 * MiB, WS_WGU = 10 * MiB, WS_WD = 22 * MiB, WS_WS = 28 * MiB;
constexpr size_t WS_XN = 32 * MiB, WS_U = 66 * MiB, WS_GV = 83 * MiB, WS_Q = 100 * MiB, WS_K = 117 * MiB, WS_V = 134 * MiB, WS_MIX = 152 * MiB, WS_X1B = 186 * MiB, WS_H = 220 * MiB, WS_END = 312 * MiB;
static_assert(WS_WIN + (size_t)NIN * DM * 2 <= WS_WO && WS_WGU + (size_t)NGU * DM * 2 <= WS_WD && WS_WD + (size_t)DM * DFF * 2 <= WS_WS && WS_XN + (size_t)M * DM * 2 <= WS_U && WS_U + (size_t)M * 512 * 2 <= WS_GV &&
              WS_MIX + (size_t)M * DM * 2 <= WS_X1B && WS_X1B + (size_t)M * DM * 2 <= WS_H && WS_H + (size_t)M * DFF * 2 <= WS_END, "d_ws map");
constexpr int CW_TMO = 0, CW_CODE = 1, CW_QUEUE = 64, CW_BAR = 4096, CW_ST1 = 16384, CW_ST2 = CW_ST1 + M, CW_SS = CW_ST2 + M, CW_RS = CW_SS + M, CW_END = CW_RS + M;
static_assert(CW_END * 4 <= (int)CTL_ZERO_BYTES, "CTL words inside the memset region");
static_assert(pg8::EW_U == WS_U && pg8::EW_GV == WS_GV && pg8::EW_Q == WS_Q && pg8::EW_K == WS_K && pg8::EW_V == WS_V && pg8::EW_X1B == WS_X1B && pg8::EW_H == WS_H && pg8::EC_ST1 == CW_ST1 && pg8::EC_ST2 == CW_ST2 && pg8::EC_SS == CW_SS && pg8::EC_RS == CW_RS && pg8::EW_XN == WS_XN && pg8::EO_KP == O_KP && pg8::EO_VP == O_VP && pg8::EO_KS == O_KS && pg8::EO_VS == O_VS && WS_CTL == 0, "epilogue constants match the maps");
constexpr int RING_OFF = 0, RING_BYTES = 131072;
constexpr int LDSCTL_OFF = RING_BYTES, MISC_OFF = LDSCTL_OFF + 320, RED_OFF = RING_BYTES + 1024;
constexpr int LDS_BYTES = 147456;
static_assert(RED_OFF + 4096 + 8192 <= LDS_BYTES, "LDS map");

#define GAS __attribute__((address_space(1)))
#define LAS __attribute__((address_space(3)))
typedef unsigned short bf16;
typedef unsigned v4u __attribute__((ext_vector_type(4)));
typedef unsigned v2u __attribute__((ext_vector_type(2)));
typedef float f32x4 __attribute__((ext_vector_type(4)));
typedef float f32x16 __attribute__((ext_vector_type(16)));
typedef short bf16x8 __attribute__((ext_vector_type(8)));
typedef short v4i16_t __attribute__((ext_vector_type(4)));
typedef GAS unsigned gu32;
#define RLX_AGENT __ATOMIC_RELAXED, __HIP_MEMORY_SCOPE_AGENT
#define LDS_WAIT() asm volatile("s_waitcnt lgkmcnt(0)" ::: "memory")
#define VM_WAIT() asm volatile("s_waitcnt vmcnt(0)" ::: "memory")
__device__ __forceinline__ unsigned f2bf(float f) { unsigned u = __builtin_bit_cast(unsigned, f); return (u + 0x7fffu + ((u >> 16) & 1u)) >> 16; }
__device__ __forceinline__ unsigned pk2(float lo, float hi) { return pg8::cvt_pk_bf16(lo, hi); }
__device__ __forceinline__ float bf_lo(unsigned w) { return __builtin_bit_cast(float, w << 16); }
__device__ __forceinline__ float bf_hi(unsigned w) { return __builtin_bit_cast(float, w & 0xffff0000u); }
__device__ __forceinline__ float bf2f(bf16 b) { return __builtin_bit_cast(float, (unsigned)b << 16); }

#define XB_TMO      128
#define XB_XCNT(j)  (256  + 64 * (j))
#define XB_XSUB(j)  (1280 + 64 * (j))
#define XB_XGEN(j)  (2304 + 64 * (j))
#define XB_TOP      3328
#define XB_TOPGEN   3392
#define XCD_BAR_WORDS 3456
#define XB_SPIN_CAP (1u << 18)

__device__ __forceinline__ unsigned xb_ld(unsigned* p)              { return __hip_atomic_load(p, __ATOMIC_RELAXED, __HIP_MEMORY_SCOPE_AGENT); }
__device__ __forceinline__ unsigned xb_add(unsigned* p, unsigned v) { return __hip_atomic_fetch_add(p, v, __ATOMIC_RELAXED, __HIP_MEMORY_SCOPE_AGENT); }
__device__ __forceinline__ unsigned xb_xcc_id() { return (unsigned)__builtin_amdgcn_s_getreg((3 << 11) | 20) & 0xFu; }
#define XB_SPIN(cond, bar) do { unsigned _sp = 0; while (cond) { __builtin_amdgcn_s_sleep(1); \
    if ((++_sp & 255u) == 0u) { if (xb_ld(&(bar)[XB_TMO])) break; if (_sp > XB_SPIN_CAP) { atomicAdd(&(bar)[XB_TMO], 1u); break; } } } } while (0)

struct XcdBarrier {
    unsigned* bar; unsigned x;
    volatile LAS unsigned* st;
};

__device__ __forceinline__ XcdBarrier xcd_barrier_post(unsigned* bar, volatile LAS unsigned* st) {
    XcdBarrier b; b.bar = bar; b.x = xb_xcc_id(); b.st = st;
    if (threadIdx.x == 0) (void)xb_add(&bar[XB_XCNT(b.x)], 1u);
    return b;
}
__device__ __forceinline__ void xcd_barrier_complete(unsigned* bar, unsigned x, unsigned& nloc, unsigned& nx) {
    const unsigned G = gridDim.x * gridDim.y * gridDim.z;
    unsigned sum, cnt, mine, sp = 0u;
    for (;;) {
        sum = 0u; cnt = 0u; mine = 0u;
#pragma unroll
        for (unsigned j = 0; j < 16; ++j) { const unsigned c = xb_ld(&bar[XB_XCNT(j)]); sum += c; cnt += (c > 0u) ? 1u : 0u; mine = (j == x) ? c : mine; }
        if (sum == G) break;
        __builtin_amdgcn_s_sleep(1);
        if ((++sp & 255u) == 0u) { if (xb_ld(&bar[XB_TMO])) break; if (sp > XB_SPIN_CAP) { atomicAdd(&bar[XB_TMO], 1u); break; } }
    }
    nloc = mine > 0u ? mine : 1u; nx = cnt > 0u ? cnt : 1u;
}

__device__ __forceinline__ void xcd_barrier(const XcdBarrier& b) {
    asm volatile("s_waitcnt vmcnt(0)" ::: "memory");
    __syncthreads();
    if (threadIdx.x == 0) {
        unsigned* bar = b.bar;
        __builtin_amdgcn_s_waitcnt(0);
        unsigned nloc = b.st[0], nx = b.st[1];
        if (nloc == 0u) { xcd_barrier_complete(bar, b.x, nloc, nx); b.st[0] = nloc; b.st[1] = nx; }
        const unsigned old = xb_add(&bar[XB_XSUB(b.x)], 1u);
        const unsigned gen = old / nloc;
        if (old + 1u == (gen + 1u) * nloc) {
            __builtin_amdgcn_fence(__ATOMIC_RELEASE, "agent");
            asm volatile("s_waitcnt vmcnt(0)" ::: "memory");
            const unsigned og = xb_add(&bar[XB_TOP], 1u);
            const unsigned tg = og / nx;
            if (og + 1u == (tg + 1u) * nx) xb_add(&bar[XB_TOPGEN], 1u);
            else XB_SPIN(xb_ld(&bar[XB_TOPGEN]) == tg, bar);
            __builtin_amdgcn_fence(__ATOMIC_ACQUIRE, "agent");
            xb_add(&bar[XB_XGEN(b.x)], 1u);
            asm volatile("s_waitcnt vmcnt(0)" ::: "memory");
        } else {
            XB_SPIN(xb_ld(&bar[XB_XGEN(b.x)]) == gen, bar);
            __builtin_amdgcn_fence(__ATOMIC_ACQUIRE, "agent");
            asm volatile("s_waitcnt vmcnt(0)" ::: "memory");
        }
    }
    __syncthreads();
}
struct Args { const float* in[19]; float* out; unsigned char* ws; int ph_lo, ph_hi; };
struct Frame {
    LAS unsigned char* lds;
    volatile LAS unsigned* MISC;
    gu32* ctl;
    int tid, lane, wave;
    int vcu, G;
    unsigned char* ws; float* out;
};

__device__ __forceinline__ float wave_sum(float v) {
#pragma unroll
    for (int o = 1; o < 64; o <<= 1) v += __shfl_xor(v, o);
    return v;
}
__device__ __forceinline__ float wave_max(float v) {
#pragma unroll
    for (int o = 1; o < 64; o <<= 1) v = fmaxf(v, __shfl_xor(v, o));
    return v;
}
__device__ __forceinline__ int win_drow(int n0) { const int sec = n0 >> 9; if (sec < 2) return n0; const int cs = n0 & 511, head = cs >> 6, dh = (cs >> 5) & 1; return 256 * (2 * sec + (head >> 2)) + 128 * dh + 32 * (head & 3); }
struct RPair { f32x4 v0[4], v1[4]; };
__device__ __forceinline__ const float* x_row(const Args& A, int m) { return (m < MP) ? A.in[0] + (size_t)m * DM : A.in[1] + (size_t)(m - MP) * DM; }
__device__ __forceinline__ void rms_pair_load(RPair& P, const Args& A, int m, int lane) {
    if (m >= M) return;
    const GAS f32x4* xr0 = (const GAS f32x4*)x_row(A, m) + lane; const GAS f32x4* xr1 = (const GAS f32x4*)x_row(A, m + 1) + lane;
#pragma unroll
    for (int j = 0; j < 4; ++j) { P.v0[j] = __builtin_nontemporal_load(xr0 + 64 * j); P.v1[j] = __builtin_nontemporal_load(xr1 + 64 * j); }
}
__device__ __forceinline__ void rms_pair_finish(const RPair& P, const float* g, bf16* obase, float* rs, int m, int lane) {
    if (m >= M) return;
    const GAS f32x4* gr = (const GAS f32x4*)g + lane; float s0 = 0.f, s1 = 0.f;
#pragma unroll
    for (int j = 0; j < 4; ++j) { s0 += (P.v0[j].x * P.v0[j].x + P.v0[j].y * P.v0[j].y) + (P.v0[j].z * P.v0[j].z + P.v0[j].w * P.v0[j].w); s1 += (P.v1[j].x * P.v1[j].x + P.v1[j].y * P.v1[j].y) + (P.v1[j].z * P.v1[j].z + P.v1[j].w * P.v1[j].w); }
    const float r0 = 1.f / sqrtf(wave_sum(s0) * (1.f / DM) + EPS), r1 = 1.f / sqrtf(wave_sum(s1) * (1.f / DM) + EPS);
    if (lane == 0) { rs[m] = r0; rs[m + 1] = r1; }
#pragma unroll
    for (int j = 0; j < 4; ++j) { const f32x4 gg = gr[64 * j]; v2u o;
        o.x = pk2(P.v0[j].x * r0 * gg.x, P.v0[j].y * r0 * gg.y); o.y = pk2(P.v0[j].z * r0 * gg.z, P.v0[j].w * r0 * gg.w); *(GAS v2u*)((GAS char*)obase + pg8::img_off(m, 4 * lane + 256 * j, DM / 64)) = o;
        o.x = pk2(P.v1[j].x * r1 * gg.x, P.v1[j].y * r1 * gg.y); o.y = pk2(P.v1[j].z * r1 * gg.z, P.v1[j].w * r1 * gg.w); *(GAS v2u*)((GAS char*)obase + pg8::img_off(m + 1, 4 * lane + 256 * j, DM / 64)) = o; }
}
constexpr int I_IN = (DM / 64) * (NIN / 32), I_O = (DM / 64) * (DM / 32), I_G = (DM / 64) * (DFF / 32), I_D = (DFF / 64) * (DM / 32), I_LATE = I_O + 2 * I_G + I_D, I_ALL = I_IN + I_LATE;
struct TItem { const float* W; const float* ks; bf16* WT; int N, Kt, drow0, k0, n0; bool ok; };
__device__ __forceinline__ TItem p0_item(const Args& A, unsigned char* ws, int u, int hi = I_ALL) {
    TItem t; t.ok = u < hi; t.ks = nullptr; t.W = A.in[5]; t.WT = (bf16*)(ws + WS_WIN); t.N = NIN; t.Kt = DM >> 6; t.drow0 = 0; t.k0 = 0; t.n0 = 0;
    if (!t.ok) return t;
    if (u < I_IN) { const int nblk = NIN / 32, kb = u / nblk, nb = u % nblk; t.k0 = 64 * kb; t.n0 = 32 * nb; t.drow0 = win_drow(32 * nb); return t; }
    int r = u - I_IN;
    if (r < I_O) { const int nblk = DM / 32, kb = r / nblk, nb = r % nblk; t.W = A.in[14]; t.WT = (bf16*)(ws + WS_WO); t.N = DM; t.k0 = 64 * kb; t.n0 = 32 * nb; t.drow0 = 32 * nb; return t; } r -= I_O;
    if (r < 2 * I_G) { const bool up = r >= I_G; if (up) r -= I_G; const int nblk = DFF / 32, kb = r / nblk, nb = r % nblk, n0 = 32 * nb;
        t.W = up ? A.in[17] : A.in[16]; t.ks = A.in[15]; t.WT = (bf16*)(ws + WS_WGU); t.N = DFF; t.k0 = 64 * kb; t.n0 = n0; t.drow0 = 256 * (n0 >> 7) + (up ? 128 : 0) + (n0 & 127); return t; } r -= 2 * I_G;
    { const int nblk = DM / 32, kb = r / nblk, nb = r % nblk; t.W = A.in[18]; t.WT = (bf16*)(ws + WS_WD); t.N = DM; t.Kt = DFF >> 6; t.k0 = 64 * kb; t.n0 = 32 * nb; t.drow0 = 32 * nb; }
    return t;
}
__device__ __forceinline__ void p0_t_load(const TItem& t, float (&w)[32], int lane) {
    if (!t.ok) return;
#pragma unroll
    for (int i = 0; i < 32; ++i) { const int kk = 2 * i + (lane >> 5); w[i] = __builtin_nontemporal_load(t.W + (size_t)(t.k0 + kk) * t.N + t.n0 + (lane & 31)); }
}
__device__ __forceinline__ void p0_t_finish(const TItem& t, const float (&w)[32], LAS float* scr, int lane) {
    if (!t.ok) return;
#pragma unroll
    for (int i = 0; i < 32; ++i) { const int kk = 2 * i + (lane >> 5); float v = w[i]; if (t.ks) v *= t.ks[t.k0 + kk]; scr[kk * 33 + (lane & 31)] = v; }
    LDS_WAIT(); asm volatile("" ::: "memory");
    const int c = lane & 7;
#pragma unroll
    for (int j = 0; j < 4; ++j) { const int n = (lane >> 3) + 8 * j; const LAS float* s = scr + (8 * c) * 33 + n;
        v4u o; o.x = pk2(s[0 * 33], s[1 * 33]); o.y = pk2(s[2 * 33], s[3 * 33]); o.z = pk2(s[4 * 33], s[5 * 33]); o.w = pk2(s[6 * 33], s[7 * 33]);
        *(GAS v4u*)((GAS char*)t.WT + pg8::img_off_b(t.drow0 + n, t.k0 + 8 * c, t.Kt)) = o; }
    LDS_WAIT(); asm volatile("" ::: "memory");
}
constexpr int I_EARLY = I_IN + I_O, I_GU_END = I_EARLY + 2 * I_G;
__device__ __forceinline__ void conv_range(Frame& F, const Args& A, int lo, int hi, int widx, int nw) {
    LAS float* scr = (LAS float*)(F.lds + RING_OFF + F.wave * 16384);
#pragma unroll 1
    for (int u0 = lo + widx; u0 < hi; u0 += 3 * nw) {
        int ln = F.lane; asm volatile("" : "+v"(ln));
        const TItem ta = p0_item(A, F.ws, u0, hi), tb = p0_item(A, F.ws, u0 + nw, hi), tc = p0_item(A, F.ws, u0 + 2 * nw, hi);
        float wa[32], wb[32], wc[32];
        p0_t_load(ta, wa, ln); p0_t_load(tb, wb, ln); p0_t_load(tc, wc, ln);
        p0_t_finish(ta, wa, scr, ln); p0_t_finish(tb, wb, scr, ln); p0_t_finish(tc, wc, scr, ln);
    }
}
__device__ __forceinline__ void conv_late(Frame& F, const Args& A, int nunits, int lo, int hi) {
    const int G = F.G, c = (int)blockIdx.x, rounds = (nunits + G - 1) / G, first_short = nunits - (rounds - 1) * G;
    const int nshort = G - first_short;
    if (nshort == 0) conv_range(F, A, lo, hi, c * NWAVES + F.wave, G * NWAVES);
    else if (c >= first_short) conv_range(F, A, lo, hi, (c - first_short) * NWAVES + F.wave, nshort * NWAVES);
}
__device__ __forceinline__ void p0_prologue(Frame& F, const Args& A) {
    LAS float* scr = (LAS float*)(F.lds + RING_OFF + F.wave * 16384);
    const int gw = F.vcu * NWAVES + F.wave, NGW = F.G * NWAVES;
#if PROBE_KIND == 4
    const unsigned long long q0 = __builtin_amdgcn_s_memrealtime();
#endif
    conv_range(F, A, 0, I_EARLY, gw, NGW);
#pragma unroll 1
    for (int m0 = 2 * gw; m0 < M; m0 += 10 * NGW) {
        int ln = F.lane; asm volatile("" : "+v"(ln));
        RPair pa, pb, pc, pd, pe; bf16* xn = (bf16*)(F.ws + WS_XN);
        rms_pair_load(pa, A, m0, ln); rms_pair_load(pb, A, m0 + 2 * NGW, ln); rms_pair_load(pc, A, m0 + 4 * NGW, ln); rms_pair_load(pd, A, m0 + 6 * NGW, ln); rms_pair_load(pe, A, m0 + 8 * NGW, ln);
        rms_pair_finish(pa, A.in[4], xn, (float*)F.ws + CW_RS, m0, ln); rms_pair_finish(pb, A.in[4], xn, (float*)F.ws + CW_RS, m0 + 2 * NGW, ln); rms_pair_finish(pc, A.in[4], xn, (float*)F.ws + CW_RS, m0 + 4 * NGW, ln); rms_pair_finish(pd, A.in[4], xn, (float*)F.ws + CW_RS, m0 + 6 * NGW, ln); rms_pair_finish(pe, A.in[4], xn, (float*)F.ws + CW_RS, m0 + 8 * NGW, ln);
    }
#if PROBE_KIND == 4
    asm volatile("s_waitcnt vmcnt(0)" ::: "memory"); const unsigned long long q1 = __builtin_amdgcn_s_memrealtime();
#endif
    for (int idx = gw; idx < 8 * 128; idx += NGW) { const int i = idx & 127;
#pragma unroll
        for (int q = 0; q < 2; ++q) { const int jj = F.lane + 64 * q; ((bf16*)(F.ws + WS_WS))[(size_t)idx * 128 + jj] = (jj <= i) ? (bf16)f2bf(A.in[8][(size_t)idx * 128 + jj]) : (bf16)0; } }
#if PROBE_KIND == 4
    asm volatile("s_waitcnt vmcnt(0)" ::: "memory"); const unsigned long long q2 = __builtin_amdgcn_s_memrealtime();
    if (blockIdx.x == 0 && F.wave == 0 && F.lane == 0) F.MISC[24] = (unsigned)(PROBE_SUB == 0 ? q1 - q0 : q2 - q1);
#endif
}
__device__ __forceinline__ float wgt(int delta, int qpos) {
    const int w = (delta <= 128 ? 1 : 0) + ((((delta & 3) == 0) && delta <= 512) ? 1 : 0) + ((((delta & 15) == 0) && delta <= 2048) ? 1 : 0);
    return ((unsigned)delta <= (unsigned)qpos) ? (float)w : 0.f;
}
__device__ __forceinline__ v4i16_t vtr(const LAS unsigned char* p) { return __builtin_amdgcn_ds_read_tr16_b64_v4i16((LAS v4i16_t*)p); }
__device__ __forceinline__ bf16x8 cat8(v4i16_t a, v4i16_t b) { return (bf16x8){a[0], a[1], a[2], a[3], b[0], b[1], b[2], b[3]}; }

struct KSet { bf16x8 kf[4]; };
__device__ __forceinline__ void a_tile_desc(int tt, int P0, int& kbase, int& stride) {
    if (tt < 6) { kbase = P0 - 2048 + 256 * tt; stride = 8; } else if (tt < 9) { kbase = P0 - 512 + 128 * (tt - 6); stride = 4; } else { kbase = P0 - 128 + 32 * (tt - 9); stride = 1; }
}
__device__ __forceinline__ void a_kstore(const v4u (&kv)[4], LAS unsigned char* slot, int lane) {
#pragma unroll
    for (int it = 0; it < 4; ++it) { const int row = (lane >> 3) + 8 * it; *(LAS v4u*)(slot + row * 128 + 16 * ((lane & 7) ^ ((row >> 1) & 7))) = kv[it]; }
}
__device__ __forceinline__ void a_kfrag(KSet& T, const LAS unsigned char* slot, int lane) {
    const int i = lane & 31, hi = lane >> 5, sw = (i >> 1) & 7;
#pragma unroll
    for (int kk = 0; kk < 4; ++kk) T.kf[kk] = *(const LAS bf16x8*)(slot + i * 128 + 16 * ((2 * kk + hi) ^ sw));
}
__device__ __forceinline__ void a_kvload(v4u (&kv)[4], v4u (&vv)[4], const bf16* Kh, const bf16* Vh, int tt, int P0, int lane) {
    int kbase, stride; a_tile_desc(tt > 20 ? 20 : tt, P0, kbase, stride);
    const int kp0 = kbase + stride * (lane >> 3), cb = 16 * (lane & 7);
#pragma unroll
    for (int it = 0; it < 4; ++it) { int kp = kp0 + 8 * stride * it; kp = kp < 0 ? 0 : (kp > SEQ - 1 ? SEQ - 1 : kp); const unsigned off = (unsigned)kp * 1024u + (unsigned)cb;
        kv[it] = *(const v4u*)((const char*)Kh + (size_t)off); vv[it] = *(const v4u*)((const char*)Vh + (size_t)off); }
}
__device__ __forceinline__ void a_vstore(const v4u (&vv)[4], LAS unsigned char* slot, int lane) {
#pragma unroll
    for (int it = 0; it < 4; ++it) *(LAS v4u*)(slot + ((lane >> 3) + 8 * it) * 128 + (lane & 7) * 16) = vv[it];
}
__device__ __forceinline__ f32x16 a_qk(const KSet& T, const bf16x8 (&qf)[4], float negb) {
    f32x16 s;
#pragma unroll
    for (int r = 0; r < 16; ++r) s[r] = negb;
#pragma unroll
    for (int kk = 0; kk < 4; ++kk) s = __builtin_amdgcn_mfma_f32_32x32x16_bf16(T.kf[kk], qf[kk], s, 0, 0, 0);
    return s;
}
template <int RANGE> __device__ __forceinline__ void a_periodic(float (&wp)[16], int P0, int qpos, int lane) {
    constexpr int ST = RANGE == 3 ? 8 : (RANGE == 2 ? 4 : 1);
    const int kb0 = RANGE == 3 ? P0 - 2048 : (RANGE == 2 ? P0 - 512 : P0 - 128);
    const int d0 = qpos - kb0 - ST * 4 * (lane >> 5);
#pragma unroll
    for (int r = 0; r < 16; ++r) { const int delta = d0 - ST * ((r & 3) + 8 * (r >> 2)); wp[r] = (RANGE == 1 ? (((delta & 3) == 0) ? 1.f : 0.f) : 0.f) + (((delta & 15) == 0) ? 1.f : 0.f); }
}
template <int RANGE>
__device__ __forceinline__ void a_softmax(f32x16 s, int tt, int P0, int qpos, int lane, const float (&wp)[16], bf16x8& pf0, bf16x8& pf1, float& lsum) {
    constexpr int ST = RANGE == 3 ? 8 : (RANGE == 2 ? 4 : 1);
    int kbase, stride; a_tile_desc(tt, P0, kbase, stride);
    const int hi = lane >> 5;
    const int d0 = qpos - kbase - ST * 4 * hi;
    const int lim3 = qpos < 2048 ? qpos : 2048;
    float ps = 0.f;
#pragma unroll
    for (int r = 0; r < 16; ++r) { const int delta = d0 - ST * ((r & 3) + 8 * (r >> 2)); float w;
        if (RANGE == 1) w = ((unsigned)delta <= (unsigned)qpos) ? wp[r] + (delta <= 128 ? 1.f : 0.f) : 0.f;
        else if (RANGE == 2) w = (delta <= qpos) ? wp[r] + (delta <= 512 ? 1.f : 0.f) : 0.f;
        else w = (delta <= lim3) ? wp[r] : 0.f;
        const float p = w * __builtin_amdgcn_exp2f(s[r]); ps += p; s[r] = p; }
    lsum += ps;
    v4u pa, pb; pa.x = pk2(s[0], s[1]); pa.y = pk2(s[2], s[3]); pa.z = pk2(s[4], s[5]); pa.w = pk2(s[6], s[7]); pb.x = pk2(s[8], s[9]); pb.y = pk2(s[10], s[11]); pb.z = pk2(s[12], s[13]); pb.w = pk2(s[14], s[15]);
    pf0 = __builtin_bit_cast(bf16x8, pa); pf1 = __builtin_bit_cast(bf16x8, pb);
}
__device__ __forceinline__ void a_pv(const bf16x8 pf0, const bf16x8 pf1, int lane, const LAS unsigned char* slot, f32x16& o0, f32x16& o1) {
    const int ii = lane & 15, hi = lane >> 5;
    const LAS unsigned char* vb = slot + (4 * hi + (ii >> 2)) * 128 + (16 * ((lane >> 4) & 1) + 4 * (ii & 3)) * 2;
    { const bf16x8 v00 = cat8(vtr(vb), vtr(vb + 1024)), v01 = cat8(vtr(vb + 2048), vtr(vb + 2048 + 1024));
      const bf16x8 v10 = cat8(vtr(vb + 64), vtr(vb + 64 + 1024)), v11 = cat8(vtr(vb + 64 + 2048), vtr(vb + 64 + 2048 + 1024));
      o0 = __builtin_amdgcn_mfma_f32_32x32x16_bf16(v00, pf0, o0, 0, 0, 0); o0 = __builtin_amdgcn_mfma_f32_32x32x16_bf16(v01, pf1, o0, 0, 0, 0);
      o1 = __builtin_amdgcn_mfma_f32_32x32x16_bf16(v10, pf0, o1, 0, 0, 0); o1 = __builtin_amdgcn_mfma_f32_32x32x16_bf16(v11, pf1, o1, 0, 0, 0); }
}
struct ASeq { int t, n1, n2, n3, ord, f2, f1; };
__device__ __forceinline__ int a_next(int tt, int f2, int f1) { int u = tt + 1; if (u == 6) u = 6 + f2; if (u == 9) u = 9 + f1; return u; }
__device__ __forceinline__ void a_step(ASeq& Q, v4u (&kv)[4], v4u (&vv)[4], f32x16& s_cur, int& wrange, float (&wp)[16], const bf16* Kh, const bf16* Vh, int P0, int qpos, int lane, const bf16x8 (&qf)[4], float negb,
                                       LAS unsigned char* vt, f32x16& o0, f32x16& o1, float& lsum) {
    LAS unsigned char* kslot = vt + 8192 + ((Q.ord + 1) & 1) * 4096;
    a_kstore(kv, kslot, lane); a_vstore(vv, vt + ((Q.ord + 1) & 1) * 4096, lane);
    a_kvload(kv, vv, Kh, Vh, Q.n3, P0, lane);
    f32x16 s_next; { KSet KA; a_kfrag(KA, kslot, lane); s_next = a_qk(KA, qf, negb); }
    const int range = Q.t < 6 ? 3 : (Q.t < 9 ? 2 : 1);
    if (range != wrange) { wrange = range; if (range == 3) a_periodic<3>(wp, P0, qpos, lane); else if (range == 2) a_periodic<2>(wp, P0, qpos, lane); else a_periodic<1>(wp, P0, qpos, lane); }
    bf16x8 pf0, pf1;
    if (range == 3) a_softmax<3>(s_cur, Q.t, P0, qpos, lane, wp, pf0, pf1, lsum);
    else if (range == 2) a_softmax<2>(s_cur, Q.t, P0, qpos, lane, wp, pf0, pf1, lsum);
    else a_softmax<1>(s_cur, Q.t, P0, qpos, lane, wp, pf0, pf1, lsum);
    a_pv(pf0, pf1, lane, vt + (Q.ord & 1) * 4096, o0, o1);
    s_cur = s_next;
    Q.t = Q.n1; Q.n1 = Q.n2; Q.n2 = Q.n3; Q.n3 = a_next(Q.n3, Q.f2, Q.f1); ++Q.ord;
}
__device__ __forceinline__ void unitA(Frame& F, const Args& A, int ua, float negb) {
    const int b = ua >> 6, g = (ua >> 3) & 7, r = ua & 7;
    int lane = (int)threadIdx.x & 63; asm volatile("" : "+v"(lane));
    const int h = F.wave, i = lane & 31, hi = lane >> 5;
    const int P0 = 256 * g + r, qpos = P0 + 8 * i;
    const size_t rowb = (size_t)b * SEQ;
    const bf16* Qp = ((bf16*)(F.ws + WS_Q)) + (rowb + qpos) * 512 + 64 * h + 8 * hi;
    bf16x8 qf[4];
#pragma unroll
    for (int kk = 0; kk < 4; ++kk) qf[kk] = *(const bf16x8*)(Qp + 16 * kk);
    const bf16* Kh = ((bf16*)(F.ws + WS_K)) + rowb * 512 + 64 * h; const bf16* Vh = ((bf16*)(F.ws + WS_V)) + rowb * 512 + 64 * h;
    LAS unsigned char* vt = F.lds + RING_OFF + h * 16384;
    f32x16 o0, o1;
#pragma unroll
    for (int q = 0; q < 16; ++q) { o0[q] = 0.f; o1[q] = 0.f; }
    float lsum = 0.f;
    int f3 = 0, f2 = 0, f1 = 0;
    while (f3 < 6 && P0 - 2048 + 256 * f3 + 248 < 0) ++f3;
    while (f2 < 3 && P0 - 512 + 128 * f2 + 124 < 0) ++f2;
    while (f1 < 12 && P0 - 128 + 32 * f1 + 31 < 0) ++f1;
    ASeq Q; Q.f2 = f2; Q.f1 = f1; Q.ord = 0;
    Q.t = f3 < 6 ? f3 : (f2 < 3 ? 6 + f2 : 9 + f1); Q.n1 = a_next(Q.t, f2, f1); Q.n2 = a_next(Q.n1, f2, f1); Q.n3 = a_next(Q.n2, f2, f1);
    v4u kv[4], vv[4], kw[4], vw[4];
    a_kvload(kv, vv, Kh, Vh, Q.t, P0, lane);
    a_kstore(kv, vt + 8192, lane); a_vstore(vv, vt, lane);
    a_kvload(kv, vv, Kh, Vh, Q.n1, P0, lane); a_kvload(kw, vw, Kh, Vh, Q.n2, P0, lane);
    f32x16 s_cur; { KSet K0; a_kfrag(K0, vt + 8192, lane); s_cur = a_qk(K0, qf, negb); }
    const int ntile = (6 - f3) + (3 - f2) + (12 - f1);
    int wrange = 0; float wp[16];
#pragma unroll
    for (int q = 0; q < 16; ++q) wp[q] = 0.f;
#pragma unroll 1
    for (int k = 0; k + 1 < ntile; k += 2) { a_step(Q, kv, vv, s_cur, wrange, wp, Kh, Vh, P0, qpos, lane, qf, negb, vt, o0, o1, lsum); a_step(Q, kw, vw, s_cur, wrange, wp, Kh, Vh, P0, qpos, lane, qf, negb, vt, o0, o1, lsum); }
    if (ntile & 1) a_step(Q, kv, vv, s_cur, wrange, wp, Kh, Vh, P0, qpos, lane, qf, negb, vt, o0, o1, lsum);
    const float lt = lsum + __shfl_xor(lsum, 32), inv = 1.0f / lt;
    float ssq = 0.f;
#pragma unroll
    for (int q = 0; q < 16; ++q) { o0[q] *= inv; o1[q] *= inv; ssq += o0[q] * o0[q] + o1[q] * o1[q]; }
    ssq += __shfl_xor(ssq, 32);
    LAS float* RED = (LAS float*)(F.lds + RED_OFF);
    if (hi == 0) RED[h * 32 + i] = ssq;
    __syncthreads();
    float tot = 0.f;
#pragma unroll
    for (int w = 0; w < 8; ++w) tot += RED[w * 32 + i];
    const float rr = 1.0f / sqrtf(tot * (1.0f / 512.0f) + EPS);
    char* mixb = (char*)(F.ws + WS_MIX); const int mrow = (int)rowb + qpos;
#pragma unroll
    for (int db = 0; db < 2; ++db)
#pragma unroll
        for (int rq = 0; rq < 4; ++rq) { const int d0 = 32 * db + 8 * rq + 4 * hi; const f32x4 gg = *(const f32x4*)(A.in[13] + 64 * h + d0);
            const float a0 = (db ? o1[4 * rq] : o0[4 * rq]) * rr * gg.x, a1 = (db ? o1[4 * rq + 1] : o0[4 * rq + 1]) * rr * gg.y, a2 = (db ? o1[4 * rq + 2] : o0[4 * rq + 2]) * rr * gg.z, a3 = (db ? o1[4 * rq + 3] : o0[4 * rq + 3]) * rr * gg.w;
            v2u w; w.x = pk2(a0, a1); w.y = pk2(a2, a3); *(v2u*)(mixb + pg8::img_off(mrow, 512 + 64 * h + d0, DM / 64)) = w; }
    __syncthreads();
}

__device__ __forceinline__ void unitB(Frame& F, const Args& A, int ub) {
    int lane = (int)threadIdx.x & 63; asm volatile("" : "+v"(lane));
    const int h = F.wave, il = lane & 31, hi = lane >> 5;
    const size_t R0 = (size_t)ub * 128;
    LAS unsigned char* vn = F.lds + RING_OFF + h * 16384;
    const bf16* Wh = ((bf16*)(F.ws + WS_WS)) + (size_t)h * 128 * 128 + (size_t)il * 128 + 8 * hi;
    bf16x8 wf[20];
#pragma unroll
    for (int ib = 0; ib < 4; ++ib)
#pragma unroll
        for (int kk = 0; kk < 2 * ib + 2; ++kk) wf[ib * (ib + 1) + kk] = *(const bf16x8*)(Wh + (size_t)ib * 32 * 128 + 16 * kk);
    { const int jl = lane >> 3, ch = lane & 7;
      v4u gvr[16]; float s1[16], s2[16];
#pragma unroll
      for (int it = 0; it < 16; ++it) { const size_t row = R0 + jl + 8 * it;
          gvr[it] = *(const v4u*)(((bf16*)(F.ws + WS_GV)) + row * 512 + 64 * h + 8 * ch);
          s1[it] = __hip_atomic_load(((float*)F.ws + CW_ST1) + row, RLX_AGENT); s2[it] = __hip_atomic_load(((float*)F.ws + CW_ST2) + row, RLX_AGENT); }
      f32x4 lg0 = *(const f32x4*)(A.in[6] + 64 * h + 8 * ch), lg1 = *(const f32x4*)(A.in[6] + 64 * h + 8 * ch + 4), lb0 = *(const f32x4*)(A.in[7] + 64 * h + 8 * ch), lb1 = *(const f32x4*)(A.in[7] + 64 * h + 8 * ch + 4);
      __builtin_amdgcn_sched_barrier(0);
#pragma unroll
      for (int it = 0; it < 16; ++it) { const int j = jl + 8 * it; const v4u gv = gvr[it];
          const float mu = s1[it] * (1.0f / 512.0f), var = s2[it] * (1.0f / 512.0f) - mu * mu, rstd = 1.0f / sqrtf(var + EPS);
          v4u o;
          o.x = pk2((bf_lo(gv.x) - mu) * rstd * lg0.x + lb0.x, (bf_hi(gv.x) - mu) * rstd * lg0.y + lb0.y); o.y = pk2((bf_lo(gv.y) - mu) * rstd * lg0.z + lb0.z, (bf_hi(gv.y) - mu) * rstd * lg0.w + lb0.w);
          o.z = pk2((bf_lo(gv.z) - mu) * rstd * lg1.x + lb1.x, (bf_hi(gv.z) - mu) * rstd * lg1.y + lb1.y); o.w = pk2((bf_lo(gv.w) - mu) * rstd * lg1.z + lb1.z, (bf_hi(gv.w) - mu) * rstd * lg1.w + lb1.w);
          *(LAS v4u*)(vn + j * 128 + ch * 16) = o; } }
    f32x16 acc[4][2];
#pragma unroll
    for (int ib = 0; ib < 4; ++ib)
#pragma unroll
        for (int db = 0; db < 2; ++db)
#pragma unroll
            for (int q = 0; q < 16; ++q) acc[ib][db][q] = 0.f;
    const int ii = lane & 15;
    const LAS unsigned char* vb = vn + (8 * hi + (ii >> 2)) * 128 + (16 * ((lane >> 4) & 1) + 4 * (ii & 3)) * 2;
#pragma unroll
    for (int ib = 0; ib < 4; ++ib) {
#pragma unroll
        for (int kk = 0; kk < 8; ++kk) if (kk < 2 * ib + 2) {
            const bf16x8 a0 = cat8(vtr(vb + kk * 2048), vtr(vb + kk * 2048 + 512)), a1 = cat8(vtr(vb + kk * 2048 + 64), vtr(vb + kk * 2048 + 64 + 512));
            acc[ib][0] = __builtin_amdgcn_mfma_f32_32x32x16_bf16(a0, wf[ib * (ib + 1) + kk], acc[ib][0], 0, 0, 0); acc[ib][1] = __builtin_amdgcn_mfma_f32_32x32x16_bf16(a1, wf[ib * (ib + 1) + kk], acc[ib][1], 0, 0, 0); }
    }
    __builtin_amdgcn_sched_barrier(0);
    v2u uur[4][8];
#pragma unroll
    for (int ib = 0; ib < 4; ++ib)
#pragma unroll
        for (int db = 0; db < 2; ++db)
#pragma unroll
            for (int rq = 0; rq < 4; ++rq) uur[ib][4 * db + rq] = *(const v2u*)(((bf16*)(F.ws + WS_U)) + (R0 + 32 * ib + il) * 512 + 64 * h + 32 * db + 8 * rq + 4 * hi);
    LAS float* RED = (LAS float*)(F.lds + RED_OFF);
#pragma unroll
    for (int ib = 0; ib < 4; ++ib) { const size_t row = R0 + 32 * ib + il; const float bsi = A.in[9][h * 128 + 32 * ib + il]; float ssq = 0.f;
#pragma unroll
        for (int db = 0; db < 2; ++db)
#pragma unroll
            for (int rq = 0; rq < 4; ++rq) { const v2u uu = uur[ib][4 * db + rq];
                float a0 = bf_lo(uu.x) * (acc[ib][db][4 * rq] + bsi), a1 = bf_hi(uu.x) * (acc[ib][db][4 * rq + 1] + bsi), a2 = bf_lo(uu.y) * (acc[ib][db][4 * rq + 2] + bsi), a3 = bf_hi(uu.y) * (acc[ib][db][4 * rq + 3] + bsi);
                acc[ib][db][4 * rq] = a0; acc[ib][db][4 * rq + 1] = a1; acc[ib][db][4 * rq + 2] = a2; acc[ib][db][4 * rq + 3] = a3; ssq += (a0 * a0 + a1 * a1) + (a2 * a2 + a3 * a3); }
        ssq += __shfl_xor(ssq, 32);
        if (hi == 0) RED[h * 128 + 32 * ib + il] = ssq; }
    __syncthreads();
#pragma unroll
    for (int ib = 0; ib < 4; ++ib) { const size_t row = R0 + 32 * ib + il; float tot = 0.f;
#pragma unroll
        for (int w = 0; w < 8; ++w) tot += RED[w * 128 + 32 * ib + il];
        const float rr = 1.0f / sqrtf(tot * (1.0f / 512.0f) + EPS);
        char* mixb = (char*)(F.ws + WS_MIX);
#pragma unroll
        for (int db = 0; db < 2; ++db)
#pragma unroll
            for (int rq = 0; rq < 4; ++rq) { const int d0 = 32 * db + 8 * rq + 4 * hi; const f32x4 gg = *(const f32x4*)(A.in[12] + 64 * h + d0);
                v2u w; w.x = pk2(acc[ib][db][4 * rq] * rr * gg.x, acc[ib][db][4 * rq + 1] * rr * gg.y); w.y = pk2(acc[ib][db][4 * rq + 2] * rr * gg.z, acc[ib][db][4 * rq + 3] * rr * gg.w); *(v2u*)(mixb + pg8::img_off((int)row, 64 * h + d0, DM / 64)) = w; } }
    __syncthreads();
}

template <int CTRL> __device__ __forceinline__ float dppf(float x) { return __builtin_bit_cast(float, __builtin_amdgcn_mov_dpp(__builtin_bit_cast(int, x), CTRL, 0xf, 0xf, true)); }
__device__ __forceinline__ float row16_sum(float v) { v += dppf<0xB1>(v); v += dppf<0x4E>(v); v += dppf<0x141>(v); v += dppf<0x128>(v); return v; }
__device__ __forceinline__ float dot4(f32x4 a, f32x4 b) { return (a.x * b.x + a.y * b.y) + (a.z * b.z + a.w * b.w); }
struct CState { f32x4 a[4]; float l[4]; };
__device__ __forceinline__ void c_row_t(const f32x4 k, const f32x4 v, int delta, const f32x4 qa, float negb, f32x4& a, float& l) {
    const float w = wgt(delta, 1 << 30);
    const float d = row16_sum(dot4(k, qa));
    const float p = w * __builtin_amdgcn_exp2f(d + negb);
    l += p; a += v * p;
}
struct CBuf { f32x4 k[8], v[8]; };
__device__ __forceinline__ void c_issue(CBuf& B, const float* kbase, const float* vbase, long rstride, int off) {
#pragma unroll
    for (int q = 0; q < 8; ++q) { B.k[q] = __builtin_nontemporal_load((const f32x4*)(kbase + (long)q * rstride + off)); B.v[q] = __builtin_nontemporal_load((const f32x4*)(vbase + (long)q * rstride + off)); }
}
__device__ __forceinline__ void c_consume(const CBuf& B, int delta0, int dstep, int tsel, const LAS float* qs, int off, float negb, CState& S) {
#pragma unroll
    for (int t = 0; t < 4; ++t) { if (tsel < 0 || tsel == t) {
        const f32x4 qa = *(const LAS f32x4*)(qs + t * 512 + off);
#pragma unroll
        for (int q = 0; q < 8; ++q) c_row_t(B.k[q], B.v[q], delta0 + q * dstep + t, qa, negb, S.a[t], S.l[t]); } }
}
__device__ __forceinline__ void c_desc(int b, int ws, long& idx, long& rstride, int& d0, int& dstep, int& tsel) {
    if (b < 4) { idx = LB - 128 + 32 * ws + 8 * b; rstride = 512; d0 = 128 - 32 * ws - 8 * b; dstep = -1; tsel = -1; }
    else { const int bb = b - 4, t = bb / 6, i = bb % 6, st = (i < 3) ? 4 : 16, j0 = 33 + 24 * ws + 8 * (i % 3); idx = LB + t - st * j0; rstride = -(long)st * 512; d0 = st * j0 - t; dstep = st; tsel = t; }
}
__device__ __forceinline__ void unitD(Frame& F, const Args& A, int n) {
    int tid = (int)threadIdx.x; asm volatile("" : "+v"(tid)); const int lane = tid & 63, w = F.wave;
    const size_t ms0 = (size_t)MP + 4 * n;
    LAS float* RED = (LAS float*)(F.lds + RED_OFF);
    {   const int col = tid, h = col >> 6;
        const float lg = A.in[6][col], lb = A.in[7][col];
        float vnv[4], a[4];
#pragma unroll
        for (int t = 0; t < 4; ++t) { const size_t row = ms0 + t; const float mu = __hip_atomic_load(((float*)F.ws + CW_ST1) + row, RLX_AGENT) * (1.0f / 512.0f), var = __hip_atomic_load(((float*)F.ws + CW_ST2) + row, RLX_AGENT) * (1.0f / 512.0f) - mu * mu, rstd = 1.0f / sqrtf(var + EPS);
            vnv[t] = (bf2f(((bf16*)(F.ws + WS_GV))[row * 512 + col]) - mu) * rstd * lg + lb; F.out[O_VC + (size_t)(4 * n + t) * 512 + col] = vnv[t]; }
#pragma unroll
        for (int i = 0; i < 4; ++i) { float s = A.in[9][h * 128 + i];
#pragma unroll
            for (int j = 0; j <= i; ++j) s += A.in[8][(size_t)(h * 128 + i) * 128 + j] * vnv[j];
            a[i] = bf2f(((bf16*)(F.ws + WS_U))[(ms0 + i) * 512 + col]) * s; const float sq = wave_sum(a[i] * a[i]); if (lane == 0) RED[w * 4 + i] = sq; }
        __syncthreads();
        const float go = A.in[12][col];
#pragma unroll
        for (int i = 0; i < 4; ++i) { float tot = 0.f;
#pragma unroll
            for (int ww = 0; ww < 8; ++ww) tot += RED[ww * 4 + i];
            *(bf16*)((char*)(F.ws + WS_MIX) + pg8::img_off((int)ms0 + i, col, DM / 64)) = (bf16)f2bf(a[i] * (1.0f / sqrtf(tot * (1.0f / 512.0f) + EPS)) * go); }
        __syncthreads();
    }
}
__device__ __forceinline__ void unitC(Frame& F, const Args& A, int n, float negb) {
    int tid = (int)threadIdx.x; asm volatile("" : "+v"(tid)); const int lane = tid & 63, w = F.wave;
    const size_t ms0 = (size_t)MP + 4 * n;
    LAS float* RED = (LAS float*)(F.lds + RED_OFF);
    CState S;
    const float* ck = A.in[2] + (size_t)n * LB * 512; const float* cv = A.in[3] + (size_t)n * LB * 512;
    const int half = w >> 2, ws = w & 3, off = 256 * half + 4 * lane;
    CBuf X, Y;
    { long idx, rs; int d0, ds, ts; c_desc(0, ws, idx, rs, d0, ds, ts); c_issue(X, ck + idx * 512, cv + idx * 512, rs, off); }
    LAS float* qs = (LAS float*)(F.lds + RING_OFF + 73728);
#pragma unroll
    for (int t = 0; t < 4; ++t) { qs[t * 512 + tid] = bf2f(((bf16*)(F.ws + WS_Q))[(ms0 + t) * 512 + tid]); S.a[t] = (f32x4){0.f, 0.f, 0.f, 0.f}; S.l[t] = 0.f; }
    __syncthreads();
#pragma unroll 1
    for (int b = 0; b < 28; b += 2) {
        long idx, rs; int d0, ds, ts, d1, ds1, ts1;
        c_desc(b + 1, ws, idx, rs, d1, ds1, ts1); c_issue(Y, ck + idx * 512, cv + idx * 512, rs, off);
        __builtin_amdgcn_sched_barrier(0);
        c_desc(b, ws, idx, rs, d0, ds, ts); c_consume(X, d0, ds, ts, qs, off, negb, S);
        __builtin_amdgcn_sched_barrier(0);
        if (b + 2 < 28) { c_desc(b + 2, ws, idx, rs, d0, ds, ts); c_issue(X, ck + idx * 512, cv + idx * 512, rs, off); }
        __builtin_amdgcn_sched_barrier(0);
        c_consume(Y, d1, ds1, ts1, qs, off, negb, S);
        __builtin_amdgcn_sched_barrier(0);
    }
    {   const f32x4 k = *(const f32x4*)(F.out + O_KS + (size_t)(4 * n + ws) * 512 + off), v = *(const f32x4*)(F.out + O_VS + (size_t)(4 * n + ws) * 512 + off);
#pragma unroll
        for (int t = 0; t < 4; ++t) { const f32x4 qa = *(const LAS f32x4*)(qs + t * 512 + off); c_row_t(k, v, t - ws, qa, negb, S.a[t], S.l[t]); } }
    LAS float* racc = (LAS float*)(F.lds + RING_OFF); LAS float* rl = (LAS float*)(F.lds + RING_OFF + 65536);
#pragma unroll
    for (int t = 0; t < 4; ++t) { *(LAS f32x4*)(racc + (ws * 4 + t) * 512 + off) = S.a[t]; if ((lane & 15) == 0) rl[(ws * 4 + t) * 8 + 4 * half + (lane >> 4)] = S.l[t]; }
    __syncthreads();
    {   const int col = tid, h = col >> 6; float o[4];
#pragma unroll
        for (int t = 0; t < 4; ++t) { float num = 0.f, den = 0.f;
#pragma unroll
            for (int ww = 0; ww < 4; ++ww) { num += racc[(ww * 4 + t) * 512 + col]; den += rl[(ww * 4 + t) * 8 + h]; }
            o[t] = num / den; const float sq = wave_sum(o[t] * o[t]); if (lane == 0) RED[w * 4 + t] = sq; }
        __syncthreads();
        const float go = A.in[13][col];
#pragma unroll
        for (int t = 0; t < 4; ++t) { float tot = 0.f;
#pragma unroll
            for (int ww = 0; ww < 8; ++ww) tot += RED[ww * 4 + t];
            *(bf16*)((char*)(F.ws + WS_MIX) + pg8::img_off((int)ms0 + t, 512 + col, DM / 64)) = (bf16)f2bf(o[t] * (1.0f / sqrtf(tot * (1.0f / 512.0f) + EPS)) * go); }
        __syncthreads();
    }
}
constexpr int NU_Q = 16 + 64 + 16 + 16;
static_assert(NDEC == 8 * 16 && NBATCH == 8, "queue split");
__device__ __forceinline__ void p2_mixers(Frame& F, const Args& A) {
    const float gqm = wave_max(fabsf(A.in[10][F.lane])), gkm = wave_max(fabsf(A.in[11][F.lane]));
    const float negb = __builtin_bit_cast(float, __builtin_amdgcn_readfirstlane(__builtin_bit_cast(int, -(8.0f * 1.4426950408889634f * 1.02f) * gqm * gkm)));
    const int myq = (int)(xb_xcc_id() & 7u);
#if PROBE_KIND == 6
    const unsigned long long pq0 = __builtin_amdgcn_s_memrealtime();
#endif
#pragma unroll 1
    for (int qq = 0; qq < 8; ++qq) {
        const int q = (myq + qq) & 7;
        for (;;) {
            if (threadIdx.x == 0) F.MISC[0] = __hip_atomic_fetch_add(F.ctl + CW_QUEUE + 64 * q, 1u, RLX_AGENT);
            __syncthreads();
            const int k = __builtin_amdgcn_readfirstlane((int)F.MISC[0]);
            __syncthreads();
            if (k >= NU_Q) break;
#if PROBE_KIND == 6
            const unsigned long long u0 = __builtin_amdgcn_s_memrealtime(); const int kind = k < 16 ? 0 : (k < 72 ? 1 : (k < 88 ? 2 : (k < 96 ? 1 : 3)));
#endif
            if (k < 16) unitC(F, A, 16 * q + k, negb);
            else if (k < 72) unitA(F, A, 64 * q + 8 * (7 - ((k - 16) >> 3)) + ((k - 16) & 7), negb);
            else if (k < 88) unitB(F, A, 16 * q + (k - 72));
            else if (k < 96) unitA(F, A, 64 * q + (k - 88), negb);
            else unitD(F, A, 16 * q + (k - 96));
#if PROBE_KIND == 6
            if (blockIdx.x == PROBE_BLK && threadIdx.x == 0 && kind == PROBE_SUB && F.MISC[24] == 0u) F.MISC[24] = (unsigned)(__builtin_amdgcn_s_memrealtime() - u0);
            if (threadIdx.x == 0 && ((PROBE_SUB == 8 && kind == 2) || (PROBE_SUB == 9 && kind == 3))) { __hip_atomic_fetch_add(F.ctl + 2048, (unsigned)(__builtin_amdgcn_s_memrealtime() - u0), RLX_AGENT); __hip_atomic_fetch_add(F.ctl + 2049, 1u, RLX_AGENT); }
            if (threadIdx.x == 0 && kind == 1 && (PROBE_SUB == 5 || (PROBE_SUB == 6 && u0 - pq0 < 4000ull) || (PROBE_SUB == 7 && u0 - pq0 >= 4000ull && u0 - pq0 < 9000ull))) { __hip_atomic_fetch_add(F.ctl + 2048, (unsigned)(__builtin_amdgcn_s_memrealtime() - u0), RLX_AGENT); __hip_atomic_fetch_add(F.ctl + 2049, 1u, RLX_AGENT); }
#endif
        }
    }
#if PROBE_KIND == 6
    if (blockIdx.x == PROBE_BLK && threadIdx.x == 0 && PROBE_SUB == 4) F.MISC[24] = (unsigned)(__builtin_amdgcn_s_memrealtime() - pq0);
    if (threadIdx.x == 0 && PROBE_SUB == 10) { __hip_atomic_fetch_max(F.ctl + 2048, (unsigned)(__builtin_amdgcn_s_memrealtime() - pq0), RLX_AGENT); __hip_atomic_fetch_add(F.ctl + 2049, 0u, RLX_AGENT); if (blockIdx.x == 0) __hip_atomic_store(F.ctl + 2049, 1u, RLX_AGENT); }
#endif
}

template <int K, int MODE>
__device__ __forceinline__ void skinny_tile(Frame& F, const Args& A, const bf16* Am  , const bf16* Bt  ) {
    int lane = (int)threadIdx.x & 63; asm volatile("" : "+v"(lane));
    const int w = F.wave, il = lane & 31, hi = lane >> 5;
    for (int tile = (int)blockIdx.x; tile < 256; tile += (int)gridDim.x) {
    const int r0 = 64 * (tile >> 5), c0 = 32 * (tile & 31);
    constexpr int KW = K / 8, NK = KW / 16;
    const char* ab = (const char*)Am; const char* bb = (const char*)Bt; const int arow = MP + r0 + il, brow = c0 + il, kc0 = w * KW + 8 * hi;
    f32x16 acc0, acc1;
#pragma unroll
    for (int q = 0; q < 16; ++q) { acc0[q] = 0.f; acc1[q] = 0.f; }
    constexpr int CH = (NK % 8 == 0) ? 8 : 11;
    static_assert(NK % CH == 0, "skinny_tile: K slice");
#pragma unroll 1
    for (int k0 = 0; k0 < NK; k0 += CH) {
        bf16x8 bf[CH], a0[CH], a1[CH];
#pragma unroll
        for (int c = 0; c < CH; ++c) { const int kc = kc0 + 16 * (k0 + c); bf[c] = *(const bf16x8*)(bb + pg8::img_off_b(brow, kc, K / 64)); a0[c] = *(const bf16x8*)(ab + pg8::img_off(arow, kc, K / 64)); a1[c] = *(const bf16x8*)(ab + pg8::img_off(arow + 32, kc, K / 64)); }
#pragma unroll
        for (int c = 0; c < CH; ++c) { acc0 = __builtin_amdgcn_mfma_f32_32x32x16_bf16(bf[c], a0[c], acc0, 0, 0, 0); acc1 = __builtin_amdgcn_mfma_f32_32x32x16_bf16(bf[c], a1[c], acc1, 0, 0, 0); }
    }
    LAS float* red = (LAS float*)(F.lds + RING_OFF);
#pragma unroll
    for (int q = 0; q < 16; ++q) { red[((w * 2 + 0) * 16 + q) * 64 + lane] = acc0[q]; red[((w * 2 + 1) * 16 + q) * 64 + lane] = acc1[q]; }
    __syncthreads();
    const int rb = w >> 2, qg = w & 3;
    f32x4 v = (f32x4){0.f, 0.f, 0.f, 0.f};
#pragma unroll
    for (int ww = 0; ww < 8; ++ww)
#pragma unroll
        for (int j = 0; j < 4; ++j) v[j] += red[((ww * 2 + rb) * 16 + 4 * qg + j) * 64 + lane];
    const int srow = r0 + 32 * rb + il, col = c0 + 8 * qg + 4 * hi;
    float* yp = F.out + O_Y + (size_t)(MP + srow) * DM + col;
    if (MODE == 0) {
        const f32x4 x = *(const f32x4*)(A.in[1] + (size_t)srow * DM + col); v = v + x;
        v2u o; o.x = pk2(v[0], v[1]); o.y = pk2(v[2], v[3]); *(v2u*)((char*)(F.ws + WS_X1B) + pg8::img_off(MP + srow, col, DM / 64)) = o;
        float s = (v[0] * v[0] + v[1] * v[1]) + (v[2] * v[2] + v[3] * v[3]); s += __shfl_xor(s, 32);
        if (hi == 0) atomicAdd((float*)F.ws + CW_SS + MP + srow, s);
    } else {
        const v2u xb = *(const v2u*)((const char*)(F.ws + WS_X1B) + pg8::img_off(MP + srow, col, DM / 64)); *(f32x4*)yp = v + (f32x4){bf_lo(xb.x), bf_hi(xb.x), bf_lo(xb.y), bf_hi(xb.y)};
    }
    __syncthreads();
    }
}
#ifndef PROBE_KIND
#define PROBE_KIND 0
#endif
#ifndef PROBE_PH
#define PROBE_PH 2
#endif
#ifndef PROBE_MUL
#define PROBE_MUL 4
#endif
#ifndef PROBE_BLK
#define PROBE_BLK 0
#endif
#ifndef PROBE_SUB
#define PROBE_SUB 0
#endif
__global__ void __launch_bounds__(NWAVES * 64, 2) hymba_fwd(Args args) {
    unsigned long long pr_t0 = 0, pr_dt = 0;
#define PR_BEGIN(k) do { if (PROBE_KIND == 1 && PROBE_PH == (k)) pr_t0 = __builtin_amdgcn_s_memrealtime(); } while (0)
#define PR_END(k) do { if (PROBE_KIND == 1 && PROBE_PH == (k)) pr_dt = __builtin_amdgcn_s_memrealtime() - pr_t0; } while (0)
    extern __shared__ __attribute__((aligned(16))) unsigned char lds[];
    Frame F;
    F.lds = (LAS unsigned char*)lds;
    F.MISC = (volatile LAS unsigned*)(F.lds + MISC_OFF);
    F.tid = threadIdx.x; F.lane = F.tid & 63; F.wave = __builtin_amdgcn_readfirstlane(F.tid >> 6);
    F.G = gridDim.x; { const int bx = blockIdx.x; F.vcu = (F.G % 8 == 0) ? (bx % 8) * (F.G / 8) + bx / 8 : bx; }
    unsigned char* ws = args.ws;
    F.ctl = (gu32*)(ws + WS_CTL); F.ws = ws; F.out = args.out;
    for (int u = F.tid; u < (LDS_BYTES - LDSCTL_OFF) / 4; u += NWAVES * 64) ((LAS unsigned*)(F.lds + LDSCTL_OFF))[u] = 0u;
    __syncthreads();
    XcdBarrier bar; bar.bar = (unsigned*)(F.ctl + CW_BAR); bar.x = 0; bar.st = nullptr;
    if (N_LAUNCHES != PER_PHASE) bar = xcd_barrier_post((unsigned*)(F.ctl + CW_BAR), F.MISC + 8);
#define GRID_BAR(seam) do { if (N_LAUNCHES == PER_PHASE) { if (F.tid == 0) __hip_atomic_store(F.ctl + CW_TMO, 0xBADBA0u | (unsigned)(seam), RLX_AGENT); } else { xcd_barrier(bar); } } while (0)
#if PROBE_KIND == 5
    if (F.tid == 0) __hip_atomic_store(F.ctl + 2048 + blockIdx.x, (unsigned)__builtin_amdgcn_s_memrealtime(), RLX_AGENT);
#endif
    const int lo = args.ph_lo, hi = args.ph_hi;
#define IN(k) (lo <= (k) && (k) < hi)
#define BOTH(k) (IN(k) && IN((k) + 1))
    PR_BEGIN(0);
    if (IN(0)) { p0_prologue(F, args); PR_BEGIN(10); if (BOTH(0)) GRID_BAR(0); PR_END(10); }
#if PROBE_KIND == 5
    if (blockIdx.x == 0 && F.tid == 0) { unsigned mn = 0xffffffffu, mx = 0u; const unsigned t0w = __hip_atomic_load(F.ctl + 2048, RLX_AGENT); for (int i = 0; i < (int)gridDim.x; ++i) { const unsigned v = __hip_atomic_load(F.ctl + 2048 + i, RLX_AGENT) - t0w + 0x40000000u; mn = v < mn ? v : mn; mx = v > mx ? v : mx; } F.MISC[24] = mx - mn; }
#endif
    PR_END(0);
    PR_BEGIN(1);
    if (IN(1)) {
        pg8::Gemm g{(const bf16*)(ws + WS_XN), (const bf16*)(ws + WS_WIN), M, NIN, DM}; pg8::StaticOrder S; S.init(M, NIN, F.G, (int)blockIdx.x);
        pg8::EpiIn E{ws, args.out, args.in[10], args.in[11]};
        pg8::gemm_phase<pg8::EpiIn, pg8::StaticOrder, PG8_ALIGN, PG8_SP2>(F.lds + RING_OFF, g, S, E);
        conv_late(F, args, (M / 256) * (NIN / 256), I_EARLY, I_GU_END);
        if (BOTH(1)) GRID_BAR(1);
    }
    PR_END(1);
    PR_BEGIN(2);
    if (IN(2)) { p2_mixers(F, args); if (BOTH(2)) GRID_BAR(2); }
    PR_END(2);
#if PROBE_KIND == 6
    if (PROBE_SUB >= 5 && blockIdx.x == PROBE_BLK && F.tid == 0) { const unsigned sm = __hip_atomic_load(F.ctl + 2048, RLX_AGENT), cn = __hip_atomic_load(F.ctl + 2049, RLX_AGENT); F.MISC[24] = cn ? sm / cn : 0u; }
#endif
    PR_BEGIN(3);
    if (IN(3)) {
        pg8::Gemm g{(const bf16*)(ws + WS_MIX), (const bf16*)(ws + WS_WO), MP, DM, DM}; pg8::StaticOrder S; S.init(MP, DM, F.G, (int)blockIdx.x);
        pg8::EpiWo E{args.in[4], ws};
        pg8::gemm_phase<pg8::EpiWo, pg8::StaticOrder, PG8_ALIGN, PG8_SP2>(F.lds + RING_OFF, g, S, E);
        skinny_tile<DM, 0>(F, args, (const bf16*)(ws + WS_MIX), (const bf16*)(ws + WS_WO));
        if (BOTH(3)) GRID_BAR(3);
    }
    PR_END(3);
    PR_BEGIN(4);
    if (IN(4)) {
        pg8::Gemm g{(const bf16*)(ws + WS_X1B), (const bf16*)(ws + WS_WGU), M, NGU, DM}; pg8::StaticOrder S; S.init(M, NGU, F.G, (int)blockIdx.x);
        pg8::EpiGU E{ws};
        pg8::gemm_phase<pg8::EpiGU, pg8::StaticOrder, PG8_ALIGN, PG8_SP2>(F.lds + RING_OFF, g, S, E);
        conv_late(F, args, (M / 256) * (NGU / 256), I_GU_END, I_ALL);
        if (BOTH(4)) GRID_BAR(4);
    }
    PR_END(4);
    PR_BEGIN(5);
    if (IN(5)) {
        pg8::Gemm g{(const bf16*)(ws + WS_H), (const bf16*)(ws + WS_WD), MP, DM, DFF}; pg8::StaticOrder S; S.init(MP, DM, F.G, (int)blockIdx.x);
        pg8::EpiDown E{args.out, ws};
        pg8::gemm_phase<pg8::EpiDown, pg8::StaticOrder, PG8_ALIGN, PG8_SP2>(F.lds + RING_OFF, g, S, E);
        skinny_tile<DFF, 1>(F, args, (const bf16*)(ws + WS_H), (const bf16*)(ws + WS_WD));
    }
    PR_END(5);
    if (PROBE_KIND != 0) {
        __syncthreads();
        if (PROBE_KIND != 1) pr_dt = (unsigned long long)F.MISC[24];
        if (blockIdx.x == PROBE_BLK && F.tid == 0) { const unsigned long long t = __builtin_amdgcn_s_memrealtime(); while (__builtin_amdgcn_s_memrealtime() - t < (unsigned long long)PROBE_MUL * pr_dt) __builtin_amdgcn_s_sleep(20); }
    }
#undef IN
#undef BOTH
}

extern "C" void kernel_launch(void* const* d_in, const int* in_sizes, int n_in, void* d_out, int out_size, void* d_ws, size_t ws_size, hipStream_t stream) {
    static int grid = 0;
    if (grid == 0) {
        if (n_in != 19 || in_sizes[0] != MP * DM || in_sizes[1] != MS * DM || (size_t)out_size != O_END || ws_size < WS_END) { fprintf(stderr, "kernel_launch: unexpected shapes (n_in %d, in0 %d, out %d, ws %zu); nothing launched\n", n_in, n_in > 0 ? in_sizes[0] : -1, out_size, ws_size); grid = -1; return; }
        int dev = 0, cus = 0, per_cu = 0;
        if (hipGetDevice(&dev) != hipSuccess || hipDeviceGetAttribute(&cus, hipDeviceAttributeMultiprocessorCount, dev) != hipSuccess) { grid = -1; return; }
        if (hipFuncSetAttribute((const void*)hymba_fwd, hipFuncAttributeMaxDynamicSharedMemorySize, LDS_BYTES) != hipSuccess) { fprintf(stderr, "kernel_launch: hipFuncSetAttribute failed\n"); grid = -1; return; }
        if (hipOccupancyMaxActiveBlocksPerMultiprocessor(&per_cu, (const void*)hymba_fwd, NWAVES * 64, LDS_BYTES) != hipSuccess || per_cu < 1) fprintf(stderr, "kernel_launch: occupancy query reports %d\n", per_cu);
        (void)hipGetLastError();
        grid = cus;
    }
    if (grid < 0) return;
    if (hipMemsetAsync((char*)d_ws + WS_CTL, 0, CTL_ZERO_BYTES, stream) != hipSuccess) { fprintf(stderr, "kernel_launch: hipMemsetAsync failed\n"); return; }
    Args a{};
    for (int i = 0; i < 19; ++i) a.in[i] = (const float*)d_in[i];
    a.out = (float*)d_out; a.ws = (unsigned char*)d_ws;
    for (int li = 0; li < N_LAUNCHES; ++li) {
        a.ph_lo = (N_LAUNCHES == PER_PHASE) ? li : 0; a.ph_hi = (N_LAUNCHES == PER_PHASE) ? li + 1 : PER_PHASE;
        hipLaunchKernelGGL(hymba_fwd, dim3(grid), dim3(NWAVES * 64), LDS_BYTES, stream, a);
        const hipError_t le = hipPeekAtLastError();
        if (le != hipSuccess) { fprintf(stderr, "kernel_launch: launch %d failed: %s\n", li, hipGetErrorName(le)); break; }
    }
}
```
